# Optimizing an MI355X kernel written in HIP

```python
import math
import jax
import jax.numpy as jnp
from jax import lax
import numpy as np

D_MODEL = 1024
BATCH = 4
SEQ = 8192
DEPTH = 4

HEAD_DIM = 64
N_HEADS = D_MODEL // HEAD_DIM
D_INNER = N_HEADS * HEAD_DIM
N_MIXERS = 4
ROPE_THETA = 500000.0
ROT_DIM = HEAD_DIM // 4
Q_BLOCK = 128
LN_EPS = 1e-5
DN_ALPHA = (2.0 * DEPTH) ** 0.25
DN_BETA = (8.0 * DEPTH) ** -0.25
MOBA_BLOCK = 256
MOBA_TOPK = 3
MOBA_Q_CHUNK = 16
SWA_WINDOW = 128
SWA_KV_HEADS = 4
DILATED_GROUPS = ((128, 1), (512, 4), (2048, 16))

SB_IN = 4 * D_INNER
MOBA_IN = 4 * D_INNER
SWA_IN = 2 * D_INNER + 2 * SWA_KV_HEADS * HEAD_DIM
DIL_IN = (3 * len(DILATED_GROUPS) + 1) * D_INNER

kernel_name = 'hybrid_sb_moba_swa_dilated_deepnorm'


def layer_norm(x, g, b):
    xf = x.astype(jnp.float32)
    mu = jnp.mean(xf, axis=-1, keepdims=True)
    var = jnp.mean(jnp.square(xf - mu), axis=-1, keepdims=True)
    return ((xf - mu) * lax.rsqrt(var + LN_EPS) * g + b).astype(x.dtype)


def split_cols(p, sizes):
    idx = [int(c) for c in np.cumsum(sizes)[:-1]]
    return jnp.split(p, idx, axis=-1)


def rope_tables(seq_len):
    pos = jnp.arange(seq_len, dtype=jnp.float32)
    inv = ROPE_THETA ** (-jnp.arange(0, ROT_DIM, 2, dtype=jnp.float32) / ROT_DIM)
    ang = pos[:, None] * inv[None, :]
    return jnp.cos(ang)[:, None, :], jnp.sin(ang)[:, None, :]


def partial_rope(x, cos, sin):
    half = ROT_DIM // 2
    x1 = x[..., :half].astype(jnp.float32)
    x2 = x[..., half:ROT_DIM].astype(jnp.float32)
    r1 = (x1 * cos - x2 * sin).astype(x.dtype)
    r2 = (x2 * cos + x1 * sin).astype(x.dtype)
    return jnp.concatenate([r1, r2, x[..., ROT_DIM:]], axis=-1)


def stick_breaking_attn(q, k, v):
    B, S, H, Dh = q.shape
    nb = S // Q_BLOCK
    scale = Dh ** -0.5
    qb = q.reshape(B, nb, Q_BLOCK, H, Dh).transpose(1, 0, 3, 2, 4)
    kt = k.transpose(0, 2, 1, 3)
    vt = v.transpose(0, 2, 1, 3)
    kpos = jnp.arange(S)

    def one_block(args):
        qi, bi = args
        tpos = bi * Q_BLOCK + jnp.arange(Q_BLOCK)
        before = kpos[None, :] < tpos[:, None]
        z = jnp.einsum('bhqd,bhsd->bhqs', qi, kt).astype(jnp.float32) * scale
        log_1m = jnp.where(before, jax.nn.log_sigmoid(-z), 0.0)
        between = lax.cumsum(log_1m, axis=3, reverse=True) - log_1m
        log_a = jnp.where(before, jax.nn.log_sigmoid(z) + between, -jnp.inf)
        return jnp.einsum('bhqs,bhsd->bhqd', jnp.exp(log_a).astype(vt.dtype), vt)

    out = lax.map(one_block, (qb, jnp.arange(nb)))
    return out.transpose(1, 0, 3, 2, 4).reshape(B, S, H, Dh)


def moba_attn(q, k, v):
    B, S, H, Dh = q.shape
    scale = Dh ** -0.5
    nkb = -(-S // MOBA_BLOCK)
    pad = nkb * MOBA_BLOCK - S
    qt = q.transpose(0, 2, 1, 3)
    kp = jnp.pad(k.transpose(0, 2, 1, 3), ((0, 0), (0, 0), (0, pad), (0, 0)))
    vp = jnp.pad(v.transpose(0, 2, 1, 3), ((0, 0), (0, 0), (0, pad), (0, 0)))
    kblk = kp.reshape(B, H, nkb, MOBA_BLOCK, Dh)
    vblk = vp.reshape(B, H, nkb, MOBA_BLOCK, Dh)
    k_mean = jnp.mean(kblk.astype(jnp.float32), axis=3)
    gate = jnp.einsum('bhsd,bhnd->bhsn', qt.astype(jnp.float32), k_mean)
    q_blk = jnp.arange(S) // MOBA_BLOCK
    fully_past = jnp.arange(nkb)[None, :] < q_blk[:, None]
    gate = jnp.where(fully_past, gate, -jnp.inf)
    topk = min(MOBA_TOPK, nkb)
    _, sel = lax.top_k(gate, topk)
    sel_ok = sel < q_blk[:, None]

    C = MOBA_Q_CHUNK
    nc = S // C
    n_sel = topk * MOBA_BLOCK
    q_c = qt.reshape(B, H, nc, C, Dh).transpose(2, 0, 1, 3, 4)
    sel_c = sel.reshape(B, H, nc, C, topk).transpose(2, 0, 1, 3, 4)
    ok_c = sel_ok.reshape(B, H, nc, C, topk).transpose(2, 0, 1, 3, 4)
    b_idx = jnp.arange(B)[:, None, None, None]
    h_idx = jnp.arange(H)[None, :, None, None]

    def one_chunk(args):
        qc, selc, okc, ci = args
        t = ci * C + jnp.arange(C)
        k_sel = kblk[b_idx, h_idx, selc]
        v_sel = vblk[b_idx, h_idx, selc]
        own = (ci * C) // MOBA_BLOCK * MOBA_BLOCK
        k_own = lax.dynamic_slice_in_dim(kp, own, MOBA_BLOCK, axis=2)
        v_own = lax.dynamic_slice_in_dim(vp, own, MOBA_BLOCK, axis=2)
        s_sel = jnp.einsum('bhqd,bhqnkd->bhqnk', qc, k_sel).astype(jnp.float32) * scale
        s_sel = jnp.where(okc[..., None], s_sel, -jnp.inf).reshape(B, H, C, n_sel)
        s_own = jnp.einsum('bhqd,bhkd->bhqk', qc, k_own).astype(jnp.float32) * scale
        s_own = jnp.where((own + jnp.arange(MOBA_BLOCK))[None, :] <= t[:, None], s_own, -jnp.inf)
        p = jax.nn.softmax(jnp.concatenate([s_sel, s_own], axis=-1), axis=-1).astype(v.dtype)
        o = jnp.einsum('bhqnk,bhqnkd->bhqd', p[..., :n_sel].reshape(B, H, C, topk, MOBA_BLOCK), v_sel)
        return o + jnp.einsum('bhqk,bhkd->bhqd', p[..., n_sel:], v_own)

    out = lax.map(one_chunk, (q_c, sel_c, ok_c, jnp.arange(nc)))
    return out.transpose(1, 0, 3, 2, 4).reshape(B, S, H, Dh)


def banded_attn(q, k, v, max_back, sink_logits=None):
    N, L, H, Dh = q.shape
    G = k.shape[2]
    R = H // G
    scale = Dh ** -0.5
    nb = -(-L // Q_BLOCK)
    Lp = nb * Q_BLOCK
    n_prev = -(-max_back // Q_BLOCK)
    span = (n_prev + 1) * Q_BLOCK
    qb = jnp.pad(q, ((0, 0), (0, Lp - L), (0, 0), (0, 0))).reshape(N, nb, Q_BLOCK, G, R, Dh)
    kv_pad = ((0, 0), (n_prev * Q_BLOCK, Lp - L), (0, 0), (0, 0))
    kp = jnp.pad(k, kv_pad)
    vp = jnp.pad(v, kv_pad)

    def band(t):
        return jnp.concatenate(
            [t[:, j * Q_BLOCK:j * Q_BLOCK + Lp].reshape(N, nb, Q_BLOCK, G, Dh) for j in range(n_prev + 1)],
            axis=2)

    kb = band(kp)
    vb = band(vp)
    s = jnp.einsum('nbqgrd,nbkgd->nbgrqk', qb, kb).astype(jnp.float32) * scale
    rel = jnp.arange(span) - n_prev * Q_BLOCK
    dist = jnp.arange(Q_BLOCK)[:, None] - rel[None, :]
    key_pos = (jnp.arange(nb) * Q_BLOCK)[:, None] + rel[None, :]
    valid = ((dist >= 0) & (dist <= max_back))[None] & (key_pos >= 0)[:, None, :]
    s = jnp.where(valid[None, :, None, None], s, -jnp.inf)
    m = jnp.max(s, axis=-1, keepdims=True)
    if sink_logits is not None:
        sink = sink_logits.astype(jnp.float32).reshape(1, 1, G, R, 1, 1)
        m = jnp.maximum(m, sink)
    e = jnp.exp(s - m)
    den = jnp.sum(e, axis=-1, keepdims=True)
    if sink_logits is not None:
        den = den + jnp.exp(sink - m)
    o = jnp.einsum('nbgrqk,nbkgd->nbqgrd', (e / den).astype(v.dtype), vb)
    lse = (m + jnp.log(den))[..., 0]
    o = o.reshape(N, Lp, H, Dh)[:, :L]
    lse = lse.transpose(0, 1, 4, 2, 3).reshape(N, Lp, H)[:, :L]
    return o, lse


def dilated_attn(q, k, v, window, dilation):
    B, S, H, Dh = q.shape
    L = S // dilation

    def to_streams(t):
        return t.reshape(B, L, dilation, H, Dh).transpose(0, 2, 1, 3, 4).reshape(B * dilation, L, H, Dh)

    o, lse = banded_attn(to_streams(q), to_streams(k), to_streams(v), window // dilation)
    o = o.reshape(B, dilation, L, H, Dh).transpose(0, 2, 1, 3, 4).reshape(B, S, H, Dh)
    lse = lse.reshape(B, dilation, L, H).transpose(0, 2, 1, 3).reshape(B, S, H)
    return o, lse


def stick_breaking_branch(h, w_in):
    B, S, _ = h.shape
    q, k, v, z = split_cols(h @ w_in, (D_INNER, D_INNER, D_INNER, D_INNER))
    shp = (B, S, N_HEADS, HEAD_DIM)
    y = stick_breaking_attn(q.reshape(shp), k.reshape(shp), v.reshape(shp))
    return y.reshape(B, S, D_INNER), z


def moba_branch(h, w_in, cos, sin):
    B, S, _ = h.shape
    q, k, v, z = split_cols(h @ w_in, (D_INNER, D_INNER, D_INNER, D_INNER))
    shp = (B, S, N_HEADS, HEAD_DIM)
    q = partial_rope(q.reshape(shp), cos, sin)
    k = partial_rope(k.reshape(shp), cos, sin)
    y = moba_attn(q, k, v.reshape(shp))
    return y.reshape(B, S, D_INNER), z


def swa_branch(h, w_in, sinks, cos, sin):
    B, S, _ = h.shape
    kvw = SWA_KV_HEADS * HEAD_DIM
    q, k, v, z = split_cols(h @ w_in, (D_INNER, kvw, kvw, D_INNER))
    q = partial_rope(q.reshape(B, S, N_HEADS, HEAD_DIM), cos, sin)
    k = partial_rope(k.reshape(B, S, SWA_KV_HEADS, HEAD_DIM), cos, sin)
    v = v.reshape(B, S, SWA_KV_HEADS, HEAD_DIM)
    y, _ = banded_attn(q, k, v, SWA_WINDOW - 1, sinks)
    return y.reshape(B, S, D_INNER), z


def dilated_branch(h, w_in, cos, sin):
    B, S, _ = h.shape
    n_g = len(DILATED_GROUPS)
    parts = split_cols(h @ w_in, (D_INNER,) * (3 * n_g + 1))
    z = parts[-1]
    shp = (B, S, N_HEADS, HEAD_DIM)
    outs = []
    lses = []
    for g, (window, dil) in enumerate(DILATED_GROUPS):
        q = partial_rope(parts[3 * g].reshape(shp), cos, sin)
        k = partial_rope(parts[3 * g + 1].reshape(shp), cos, sin)
        v = parts[3 * g + 2].reshape(shp)
        o, lse = dilated_attn(q, k, v, window, dil)
        outs.append(o)
        lses.append(lse)
    wts = jax.nn.softmax(jnp.stack(lses), axis=0)
    o_all = jnp.stack(outs)
    y = jnp.einsum('gbsh,gbshd->bshd', wts.astype(o_all.dtype), o_all)
    return y.reshape(B, S, D_INNER), z


def setup_inputs(seed: int = 0) -> dict:
    key = jax.random.key(seed)
    ks = jax.random.split(key, 20)

    def w(k, fan_in, fan_out, scale=1.0):
        return jax.random.normal(k, (fan_in, fan_out), jnp.float32) * (scale * fan_in ** -0.5)

    def gain(k):
        return 1.0 + 0.02 * jax.random.normal(k, (D_MODEL,), jnp.float32)

    def bias(k):
        return 0.02 * jax.random.normal(k, (D_MODEL,), jnp.float32)

    return {
        'x': jax.random.normal(ks[0], (BATCH, SEQ, D_MODEL), jnp.float32),
        'sb_w_in': w(ks[1], D_MODEL, SB_IN),
        'sb_w_out': w(ks[2], D_INNER, D_MODEL, DN_BETA),
        'ln0_g': gain(ks[3]),
        'ln0_b': bias(ks[4]),
        'moba_w_in': w(ks[5], D_MODEL, MOBA_IN),
        'moba_w_out': w(ks[6], D_INNER, D_MODEL, DN_BETA),
        'ln1_g': gain(ks[7]),
        'ln1_b': bias(ks[8]),
        'swa_w_in': w(ks[9], D_MODEL, SWA_IN),
        'swa_sinks': 0.5 * jax.random.normal(ks[10], (N_HEADS,), jnp.float32),
        'swa_w_out': w(ks[11], D_INNER, D_MODEL, DN_BETA),
        'ln2_g': gain(ks[12]),
        'ln2_b': bias(ks[13]),
        'dil_w_in': w(ks[14], D_MODEL, DIL_IN),
        'dil_w_out': w(ks[15], D_INNER, D_MODEL, DN_BETA),
        'ln3_g': gain(ks[16]),
        'ln3_b': bias(ks[17]),
    }


def reference(x, sb_w_in, sb_w_out, ln0_g, ln0_b, moba_w_in, moba_w_out, ln1_g, ln1_b,
              swa_w_in, swa_sinks, swa_w_out, ln2_g, ln2_b, dil_w_in, dil_w_out, ln3_g, ln3_b):
    S = x.shape[1]
    cos, sin = rope_tables(S)
    mixers = (
        lambda h: stick_breaking_branch(h, sb_w_in),
        lambda h: moba_branch(h, moba_w_in, cos, sin),
        lambda h: swa_branch(h, swa_w_in, swa_sinks, cos, sin),
        lambda h: dilated_branch(h, dil_w_in, cos, sin),
    )
    w_outs = (sb_w_out, moba_w_out, swa_w_out, dil_w_out)
    ln_gs = (ln0_g, ln1_g, ln2_g, ln3_g)
    ln_bs = (ln0_b, ln1_b, ln2_b, ln3_b)
    for i in range(DEPTH):
        m = i % N_MIXERS
        y, z = mixers[m](x)
        out = (y * jax.nn.silu(z)) @ w_outs[m]
        x = layer_norm(DN_ALPHA * x + out, ln_gs[m], ln_bs[m])
    return x
```

```cpp
#include <hip/hip_runtime.h>
#include <hip/hip_cooperative_groups.h>
#include <cstdio>
#include <cstdint>
#include <cmath>
namespace cg = cooperative_groups;
namespace pg8 {
#define PG8_LAS __attribute__((address_space(3)))
typedef unsigned short bf16_t;
typedef short bf16x8 __attribute__((ext_vector_type(8)));
typedef float f32x4 __attribute__((ext_vector_type(4)));
typedef unsigned u32x4 __attribute__((ext_vector_type(4)));
typedef unsigned u32x2 __attribute__((ext_vector_type(2)));
constexpr int BM = 256, BK = 64, HALF = 128, HTB = HALF * BK * 2  , STAGE_BYTES = 8 * HTB, NXCD = 8, WGM = 8;

__host__ __device__ __forceinline__ int lds_byte(int r, int c) { const int st = (r >> 4) * 2 + (c >> 5), rr = r & 15, cc = c & 31, ob = rr * 64 + cc * 2; return st * 1024 + (ob ^ (((ob >> 9) & 1) << 5)); }
__host__ __device__ __forceinline__ void stage_rc(int b, int& R, int& C) { const int st = b / 1024, sb = b % 1024, swz = sb ^ (((sb >> 9) & 1) << 5); R = (st >> 1) * 16 + swz / 64; C = (st & 1) * 32 + (swz % 64) / 2; }
__host__ __device__ __forceinline__ int perm32(int rho) { const int n = rho >> 4, i = rho & 15; return 8 * (i >> 2) + 4 * n + (i & 3); }

struct Unit { int pm, pn; };
struct Gemm { const bf16_t* A; const bf16_t* Bt; int M, N, K; };

struct StaticOrder {
    int nM, nN, nwg, G, c;
    __host__ __device__ void init(int M, int N, int G_, int c_) { nM = M / BM; nN = N / BM; nwg = nM * nN; G = G_; c = c_; }
    __host__ __device__ bool next(int i, Unit& u) const {
        const long L = (long)i * G + c; if (L >= nwg) return false;
        int wgid = (int)L; { const int q = nwg / NXCD, r = nwg % NXCD, xcd = wgid % NXCD, off = wgid / NXCD; wgid = (xcd < r ? xcd * (q + 1) : r * (q + 1) + (xcd - r) * q) + off; }
        const int nig = WGM * nN, gid = wgid / nig, fm = gid * WGM, gsz = (nM - fm) < WGM ? (nM - fm) : WGM;
        u.pm = fm + ((wgid % nig) % gsz); u.pn = (wgid % nig) / gsz; return true;
    }
    __device__ __forceinline__ void a_ready(const Unit&) const {}
    __device__ __forceinline__ void done(const Unit&) const {}
};

__device__ __forceinline__ unsigned cvt_pk_bf16(float lo, float hi) { unsigned r; asm volatile("v_cvt_pk_bf16_f32 %0, %1, %2" : "=v"(r) : "v"(lo), "v"(hi)); return r; }
struct EpiIn {
    static constexpr bool PERM = true, AFTER_DRAIN = false;
    bf16_t* O; int ldc; int layer; const float* rope;
    const float* stats; const float* cs; const float* cb; int row_off;
    __device__ __forceinline__ void operator()(const f32x4 (&acc)[2][2][4][2], const Unit& u, int wr, int wc, int fr, int fq) const {
        const int colt = u.pn * BM;
        int kind;
        if (layer == 0) { const int part = colt >> 10; kind = part == 0 ? 3 : (part == 3 ? 4 : 0); }
        else if (layer == 1) { const int part = colt >> 10; kind = part == 0 ? 2 : (part == 1 ? 1 : (part == 3 ? 4 : 0)); }
        else if (layer == 2) { kind = colt < 1024 ? 2 : (colt == 1024 ? 1 : (colt == 1280 ? 0 : 4)); }
        else { const int part = colt >> 10; const int t3 = part % 3; kind = part == 9 ? 4 : (t3 == 0 ? 2 : (t3 == 1 ? 1 : 0)); }
        const bool rope_on = (kind == 1 || kind == 2) && ((wc & 1) == 0);
        const float sc = (kind == 2 || kind == 3) ? 0.125f : 1.0f;
        const int row0 = u.pm * BM + wr * 64 + fr, col0 = colt + wc * 32 + 8 * fq;
        const bool fold = stats != nullptr;
#pragma unroll
        for (int bj = 0; bj < 2; ++bj) {
            f32x4 cs0 = {0.f, 0.f, 0.f, 0.f}, cs1 = cs0, cb0 = cs0, cb1 = cs0;
            if (fold) { const float* cp = cs + col0 + bj * HALF; const float* bp = cb + col0 + bj * HALF; cs0 = *(const f32x4*)cp; cs1 = *(const f32x4*)(cp + 4); cb0 = *(const f32x4*)bp; cb1 = *(const f32x4*)(bp + 4); }
#pragma unroll
            for (int ai = 0; ai < 2; ++ai)
#pragma unroll
                for (int m = 0; m < 4; ++m) {
                    const int row = row0 + ai * HALF + m * 16;
                    f32x4 v0 = acc[ai][bj][m][0], v1 = acc[ai][bj][m][1];
                    if (fold) { const float s1 = stats[2 * (size_t)(row + row_off)], s2 = stats[2 * (size_t)(row + row_off) + 1]; const float mu = s1 * (1.f / 1024.f), var = s2 * (1.f / 1024.f) - mu * mu;
                        const float rstd = 1.f / sqrtf(var + 1e-5f); v0 = (v0 - cs0 * mu) * rstd + cb0; v1 = (v1 - cs1 * mu) * rstd + cb1; }
                    if (rope_on) {
                        const float* rp = rope + (size_t)(row & 8191) * 16; f32x4 c0 = *(const f32x4*)rp, c1 = *(const f32x4*)(rp + 4), s0 = *(const f32x4*)(rp + 8), s1 = *(const f32x4*)(rp + 12);
                        if (fq == 0) { s0 = -s0; s1 = -s1; } if (fq >= 2) { c0 = (f32x4){1.f, 1.f, 1.f, 1.f}; c1 = c0; s0 = (f32x4){0.f, 0.f, 0.f, 0.f}; s1 = s0; }
                        f32x4 o0, o1;
#pragma unroll
                        for (int e = 0; e < 4; ++e) { o0[e] = __shfl_xor(v0[e], 16); o1[e] = __shfl_xor(v1[e], 16); }
                        v0 = v0 * c0 + o0 * s0; v1 = v1 * c1 + o1 * s1;
                    }
                    v0 = v0 * sc; v1 = v1 * sc;
                    if (kind == 4) {
#pragma unroll
                        for (int e = 0; e < 4; ++e) { v0[e] = v0[e] * __builtin_amdgcn_rcpf(1.f + __builtin_amdgcn_exp2f(-1.4426950408889634f * v0[e])); v1[e] = v1[e] * __builtin_amdgcn_rcpf(1.f + __builtin_amdgcn_exp2f(-1.4426950408889634f * v1[e])); }
                    }
                    u32x4 w; w.x = cvt_pk_bf16(v0[0], v0[1]); w.y = cvt_pk_bf16(v0[2], v0[3]); w.z = cvt_pk_bf16(v1[0], v1[1]); w.w = cvt_pk_bf16(v1[2], v1[3]);
                    *(u32x4*)(O + (size_t)row * ldc + col0 + bj * HALF) = w;
                }
        }
    }
};
struct EpiOut {
    static constexpr bool PERM = false, AFTER_DRAIN = false;
    const float* X; float* T; float alpha; const float* st_prev; const float* gp; const float* bp; float* st_out; bf16_t* XNo;
    __device__ __forceinline__ void operator()(const f32x4 (&acc)[2][2][4][2], const Unit& u, int wr, int wc, int fr, int fq) const {
        const int row0 = u.pm * BM + wr * 64 + fr, col0 = u.pn * BM + wc * 32 + 4 * fq;
        const bool prev = st_prev != nullptr;
        f32x4 gv[2][2], bv[2][2];
#pragma unroll
        for (int bj = 0; bj < 2; ++bj)
#pragma unroll
            for (int n = 0; n < 2; ++n) { if (prev) { gv[bj][n] = *(const f32x4*)(gp + col0 + bj * HALF + 16 * n); bv[bj][n] = *(const f32x4*)(bp + col0 + bj * HALF + 16 * n); } else { gv[bj][n] = (f32x4){1.f, 1.f, 1.f, 1.f}; bv[bj][n] = (f32x4){0.f, 0.f, 0.f, 0.f}; } }
#pragma unroll
        for (int ai = 0; ai < 2; ++ai)
#pragma unroll
            for (int m = 0; m < 4; ++m) {
                const int row = row0 + ai * HALF + m * 16; const size_t ro = (size_t)row * 1024 + col0;
                float mu = 0.f, rstd = 1.f;
                if (prev) { const float s1 = st_prev[2 * (size_t)row], s2 = st_prev[2 * (size_t)row + 1]; mu = s1 * (1.f / 1024.f); rstd = 1.f / sqrtf(s2 * (1.f / 1024.f) - mu * mu + 1e-5f); }
                float a1 = 0.f, a2 = 0.f;
#pragma unroll
                for (int bj = 0; bj < 2; ++bj)
#pragma unroll
                    for (int n = 0; n < 2; ++n) { const size_t o = ro + bj * HALF + 16 * n; f32x4 x = *(const f32x4*)(X + o);
                        if (prev) x = (x - mu) * rstd * gv[bj][n] + bv[bj][n];
                        const f32x4 t = x * alpha + acc[ai][bj][m][n]; *(f32x4*)(T + o) = t;
                        if (st_out) { a1 += (t[0] + t[1]) + (t[2] + t[3]); a2 += (t[0] * t[0] + t[1] * t[1]) + (t[2] * t[2] + t[3] * t[3]);
                            u32x2 w; w.x = cvt_pk_bf16(t[0], t[1]); w.y = cvt_pk_bf16(t[2], t[3]); *(u32x2*)(XNo + o) = w; } }
                if (st_out) { a1 += __shfl_xor(a1, 16); a1 += __shfl_xor(a1, 32); a2 += __shfl_xor(a2, 16); a2 += __shfl_xor(a2, 32);
                    if (fq == 0) { __hip_atomic_fetch_add(st_out + 2 * (size_t)row, a1, __ATOMIC_RELAXED, __HIP_MEMORY_SCOPE_AGENT); __hip_atomic_fetch_add(st_out + 2 * (size_t)row + 1, a2, __ATOMIC_RELAXED, __HIP_MEMORY_SCOPE_AGENT); } }
            }
    }
};
template <class Epi, class Sched, bool ALIGN_EPI = false, bool SP2 = false>
__device__ __forceinline__ void gemm_phase(PG8_LAS unsigned char* lds, const Gemm g, const Sched& S, const Epi& E) {
    int tid_ = threadIdx.x; asm volatile("" : "+v"(tid_));
    const int tid = tid_, wid = __builtin_amdgcn_readfirstlane(tid >> 6), lane = tid & 63, wr = wid >> 2, wc = wid & 3, fr = lane & 15, fq = lane >> 4;
    const int K = g.K, nt = K / BK;
    unsigned voffA[2], voffB[2];
#pragma unroll
    for (int i = 0; i < 2; ++i) { int R, C; stage_rc(tid * 16 + i * 8192, R, C); const int Rb = Epi::PERM ? ((R & ~31) + perm32(R & 31)) : R;
        voffA[i] = (unsigned)(R * K + C) * 2u; voffB[i] = (unsigned)(Rb * K + C) * 2u; }
    const size_t kstep = (size_t)(BK * 2);
    const size_t hstep = (size_t)HALF * K * 2;
    const size_t tstep = 2 * hstep;
    const unsigned ldsw = (unsigned)wid * 1024u;
    const int aoff = lds_byte(wr * 64 + fr, fq * 8), boff = lds_byte(wc * 32 + fr, fq * 8);
#define PG8_SA(b, h) (((b) * 2 + (h)) * HTB)
#define PG8_SB(b, h) ((4 + (b) * 2 + (h)) * HTB)
#define PG8_STAGE(bufoff, gbase, voff) do { _Pragma("unroll") for (int _i = 0; _i < 2; ++_i) \
        __builtin_amdgcn_global_load_lds((const unsigned*)((const char*)(gbase) + (voff)[_i]), (PG8_LAS unsigned*)(lds + (bufoff) + ldsw + _i * 8192), 16, 0, 0); } while (0)
#define PG8_LDA(dst, b, h) do { _Pragma("unroll") for (int m = 0; m < 4; ++m) _Pragma("unroll") for (int k = 0; k < 2; ++k) dst[m][k] = *(const PG8_LAS bf16x8*)(lds + PG8_SA(b, h) + aoff + m * 2048 + k * 1024); } while (0)
#define PG8_LDB(dst, b, h) do { _Pragma("unroll") for (int n = 0; n < 2; ++n) _Pragma("unroll") for (int k = 0; k < 2; ++k) dst[n][k] = *(const PG8_LAS bf16x8*)(lds + PG8_SB(b, h) + boff + n * 2048 + k * 1024); } while (0)
#define PG8_MMA(ai, bj, At, Bt) do { __builtin_amdgcn_s_setprio(1); _Pragma("unroll") for (int m = 0; m < 4; ++m) _Pragma("unroll") for (int n = 0; n < 2; ++n) _Pragma("unroll") for (int k = 0; k < 2; ++k) \
        acc[ai][bj][m][n] = __builtin_amdgcn_mfma_f32_16x16x32_bf16(Bt[n][k], At[m][k], acc[ai][bj][m][n], 0, 0, 0); __builtin_amdgcn_s_setprio(0); } while (0)
#define PG8_WAIT_V(n) asm volatile("s_waitcnt vmcnt(" #n ")" ::: "memory")
#define PG8_WAIT_L(n) asm volatile("s_waitcnt lgkmcnt(" #n ")" ::: "memory")
#define PG8_BAR __builtin_amdgcn_s_barrier()
#define PG8_SCHED __builtin_amdgcn_sched_barrier(0)
    Unit cur, nxt; int ui = 0;
    if (!S.next(0, cur)) return;
    f32x4 acc[2][2][4][2];
#pragma unroll
    for (int a = 0; a < 2; ++a)
#pragma unroll
        for (int b = 0; b < 2; ++b)
#pragma unroll
            for (int m = 0; m < 4; ++m)
#pragma unroll
                for (int n = 0; n < 2; ++n) acc[a][b][m][n] = (f32x4){0.f, 0.f, 0.f, 0.f};
    bf16x8 At[4][2], B0[2][2], B1[2][2];
    const char* cA = (const char*)g.A + (size_t)cur.pm * tstep; const char* cB = (const char*)g.Bt + (size_t)cur.pn * tstep;
    S.a_ready(cur);
    if constexpr (SP2) {
        PG8_STAGE(PG8_SB(0, 0), cB, voffB); PG8_STAGE(PG8_SB(0, 1), cB + hstep, voffB); PG8_STAGE(PG8_SA(0, 0), cA, voffA); PG8_STAGE(PG8_SA(0, 1), cA + hstep, voffA);
        if (wr == 1) PG8_BAR;
        PG8_WAIT_V(2); PG8_BAR;
        PG8_STAGE(PG8_SB(1, 0), cB + kstep, voffB); PG8_STAGE(PG8_SA(1, 0), cA + kstep, voffA); PG8_STAGE(PG8_SB(1, 1), cB + hstep + kstep, voffB);
        PG8_WAIT_V(6); PG8_BAR;
    } else {
        PG8_STAGE(PG8_SB(0, 0), cB, voffB); PG8_STAGE(PG8_SA(0, 0), cA, voffA); PG8_STAGE(PG8_SB(0, 1), cB + hstep, voffB); PG8_STAGE(PG8_SA(0, 1), cA + hstep, voffA);
        if (wr == 1) PG8_BAR;
        PG8_WAIT_V(4); PG8_BAR;
        PG8_STAGE(PG8_SB(1, 0), cB + kstep, voffB); PG8_STAGE(PG8_SA(1, 0), cA + kstep, voffA); PG8_STAGE(PG8_SB(1, 1), cB + hstep + kstep, voffB);
        PG8_WAIT_V(6); PG8_BAR;
    }
    for (;;) {
        const bool has_next = S.next(ui + 1, nxt);
        const char* nA = has_next ? (const char*)g.A + (size_t)nxt.pm * tstep : cA; const char* nB = has_next ? (const char*)g.Bt + (size_t)nxt.pn * tstep : cB;
        for (int t = 0; t < nt; t += 2) {
            const bool last = (t == nt - 2);
            const char* a1 = cA + (size_t)(t + 1) * kstep;
            const char* a2 = last ? nA : cA + (size_t)(t + 2) * kstep; const char* b2 = last ? nB : cB + (size_t)(t + 2) * kstep;
            const char* a3 = a2 + kstep; const char* b3 = b2 + kstep;
            if (last && has_next) S.a_ready(nxt);
            if constexpr (SP2) {
            PG8_LDB(B0, 0, 0); PG8_LDB(B1, 0, 1); PG8_SCHED; PG8_LDA(At, 0, 0); PG8_STAGE(PG8_SA(1, 1), a1 + hstep, voffA);
            PG8_WAIT_V(8); PG8_WAIT_L(0); PG8_BAR; PG8_MMA(0, 0, At, B0); PG8_MMA(0, 1, At, B1); PG8_BAR; PG8_SCHED;
            PG8_LDA(At, 0, 1); PG8_STAGE(PG8_SB(0, 0), b2, voffB); PG8_STAGE(PG8_SB(0, 1), b2 + hstep, voffB); PG8_STAGE(PG8_SA(0, 0), a2, voffA);
            PG8_WAIT_V(8); PG8_WAIT_L(0); PG8_BAR; PG8_MMA(1, 0, At, B0); PG8_MMA(1, 1, At, B1); PG8_BAR; PG8_SCHED;
            PG8_LDB(B0, 1, 0); PG8_LDB(B1, 1, 1); PG8_SCHED; PG8_LDA(At, 1, 0); PG8_STAGE(PG8_SA(0, 1), a2 + hstep, voffA);
            PG8_WAIT_V(8); PG8_WAIT_L(0); PG8_BAR; PG8_MMA(0, 0, At, B0); PG8_MMA(0, 1, At, B1); PG8_BAR; PG8_SCHED;
            PG8_LDA(At, 1, 1); PG8_STAGE(PG8_SB(1, 0), b3, voffB); PG8_STAGE(PG8_SB(1, 1), b3 + hstep, voffB); PG8_STAGE(PG8_SA(1, 0), a3, voffA);
            PG8_WAIT_V(8); PG8_WAIT_L(0); PG8_BAR; PG8_MMA(1, 0, At, B0); PG8_MMA(1, 1, At, B1); PG8_BAR; PG8_SCHED;
            } else {
            PG8_LDB(B0, 0, 0); PG8_SCHED; PG8_LDA(At, 0, 0); PG8_STAGE(PG8_SA(1, 1), a1 + hstep, voffA);
            PG8_WAIT_L(8); PG8_BAR; PG8_WAIT_L(0); PG8_MMA(0, 0, At, B0); PG8_BAR; PG8_SCHED;
            PG8_LDB(B1, 0, 1); PG8_STAGE(PG8_SB(0, 0), b2, voffB);
            PG8_BAR; PG8_WAIT_L(0); PG8_MMA(0, 1, At, B1); PG8_BAR;
            PG8_LDA(At, 0, 1); PG8_STAGE(PG8_SA(0, 0), a2, voffA);
            PG8_BAR; PG8_WAIT_L(0); PG8_MMA(1, 0, At, B0); PG8_BAR; PG8_SCHED;
            PG8_STAGE(PG8_SB(0, 1), b2 + hstep, voffB);
            PG8_WAIT_V(6); PG8_BAR; PG8_MMA(1, 1, At, B1); PG8_BAR;
            PG8_LDB(B0, 1, 0); PG8_SCHED; PG8_LDA(At, 1, 0); PG8_STAGE(PG8_SA(0, 1), a2 + hstep, voffA);
            PG8_WAIT_L(8); PG8_BAR; PG8_WAIT_L(0); PG8_MMA(0, 0, At, B0); PG8_BAR; PG8_SCHED;
            PG8_LDB(B1, 1, 1); PG8_STAGE(PG8_SB(1, 0), b3, voffB);
            PG8_BAR; PG8_WAIT_L(0); PG8_MMA(0, 1, At, B1); PG8_BAR;
            PG8_LDA(At, 1, 1); PG8_STAGE(PG8_SA(1, 0), a3, voffA);
            PG8_BAR; PG8_WAIT_L(0); PG8_MMA(1, 0, At, B0); PG8_BAR; PG8_SCHED;
            PG8_STAGE(PG8_SB(1, 1), b3 + hstep, voffB);
            PG8_WAIT_V(6); PG8_BAR; PG8_MMA(1, 1, At, B1); PG8_BAR;
            }
        }
        if constexpr (ALIGN_EPI) { if (wr == 0) PG8_BAR; }
        if constexpr (!Epi::AFTER_DRAIN) { E(acc, cur, wr, wc, fr, fq); S.done(cur); }
        if (!has_next) break;
#pragma unroll
        for (int a = 0; a < 2; ++a)
#pragma unroll
            for (int b = 0; b < 2; ++b)
#pragma unroll
                for (int m = 0; m < 4; ++m)
#pragma unroll
                    for (int n = 0; n < 2; ++n) acc[a][b][m][n] = (f32x4){0.f, 0.f, 0.f, 0.f};
        cur = nxt; cA = nA; cB = nB; ++ui;
        if constexpr (ALIGN_EPI) { if (wr == 1) PG8_BAR; }
    }
    PG8_WAIT_V(0);
    if constexpr (!ALIGN_EPI) { if (wr == 0) PG8_BAR; }
    PG8_BAR;
    if constexpr (Epi::AFTER_DRAIN) { E.fused(acc, cur, wr, wc, fr, fq, lds, wid, lane); S.done(cur); }
#undef PG8_SA
#undef PG8_SB
#undef PG8_STAGE
#undef PG8_LDA
#undef PG8_LDB
#undef PG8_MMA
#undef PG8_WAIT_V
#undef PG8_WAIT_L
#undef PG8_BAR
#undef PG8_SCHED
}
}
#define LAS __attribute__((address_space(3)))
typedef unsigned short bf16_t;
typedef short bf16x8 __attribute__((ext_vector_type(8)));
typedef short s16x4 __attribute__((ext_vector_type(4)));
typedef float f32x4 __attribute__((ext_vector_type(4)));
typedef unsigned u32x4 __attribute__((ext_vector_type(4)));
typedef unsigned u32x2 __attribute__((ext_vector_type(2)));

constexpr int SEQ = 8192, NBATCH = 4, MTOK = NBATCH * SEQ, DM = 1024, NWAVES = 8;
constexpr float LOG2E = 1.4426950408889634f, LN2F = 0.6931471805599453f, LN_EPS = 1e-5f, DN_ALPHA = 1.681792830507429f;
constexpr size_t MiB = 1u << 20;
constexpr size_t WS_ROPE = 0, WS_KMH = 512 * 1024, WS_KML = 768 * 1024, WS_LSE = 1 * MiB;
constexpr size_t WS_WIN0 = 10 * MiB, WS_WIN1 = 18 * MiB, WS_WIN2 = 26 * MiB, WS_WIN3 = 31 * MiB, WS_WOUT = 51 * MiB;
constexpr size_t WS_XN = 59 * MiB, WS_YG = 123 * MiB, WS_QKV = 187 * MiB, WS_END = 507 * MiB;
constexpr int LDS_BYTES = 147456, RING_BYTES = 131072, MISC_OFF = RING_BYTES + 320;
constexpr size_t WS_BAR = 9 * MiB, BAR_BYTES = 1 * MiB, WS_STATS = WS_BAR + 16 * 1024, WS_CS = WS_BAR + 784 * 1024, WS_CB = WS_CS + 120 * 1024;
constexpr int CSLD = 10240;

__device__ __forceinline__ unsigned f2bf(float f) { unsigned u = __builtin_bit_cast(unsigned, f); return (u + 0x7fffu + ((u >> 16) & 1u)) >> 16; }
__device__ __forceinline__ unsigned pk2(float lo, float hi) { return pg8::cvt_pk_bf16(lo, hi); }
__device__ __forceinline__ float bf2f(unsigned short b) { return __builtin_bit_cast(float, (unsigned)b << 16); }
__device__ __forceinline__ float bflo(unsigned w) { return __builtin_bit_cast(float, w << 16); }
__device__ __forceinline__ float bfhi(unsigned w) { return __builtin_bit_cast(float, w & 0xffff0000u); }
__device__ __forceinline__ float wave_sum(float v) {
#pragma unroll
    for (int o = 1; o < 64; o <<= 1) v += __shfl_xor(v, o);
    return v;
}
__device__ __forceinline__ float fexp2(float x) { return __builtin_amdgcn_exp2f(x); }
__device__ __forceinline__ float flog2(float x) { return __builtin_amdgcn_logf(x); }

template <bool FOLD>
__device__ __forceinline__ void transpose_item(const float* W, int K, int N, bf16_t* WT, LAS float* scr, int item, int lane, const float* gp, const float* bp, float* cs, float* cb) {
    const int nblk = N / 32, kb = item / nblk, nb = item % nblk, k0 = 64 * kb, n0 = 32 * nb;
    float wv[32];
#pragma unroll
    for (int i = 0; i < 32; ++i) wv[i] = W[(size_t)(k0 + 2 * i + (lane >> 5)) * N + n0 + (lane & 31)];
    if (FOLD) { float cbp = 0.f;
#pragma unroll
        for (int i = 0; i < 32; ++i) { const int k = k0 + 2 * i + (lane >> 5); cbp += bp[k] * wv[i]; wv[i] *= gp[k]; }
        cbp += __shfl_xor(cbp, 32);
        if (lane < 32) __hip_atomic_fetch_add(cb + n0 + lane, cbp, __ATOMIC_RELAXED, __HIP_MEMORY_SCOPE_AGENT); }
#pragma unroll
    for (int i = 0; i < 32; ++i) scr[(2 * i + (lane >> 5)) * 33 + (lane & 31)] = wv[i];
    asm volatile("s_waitcnt lgkmcnt(0)" ::: "memory");
    const int c = lane & 7;
#pragma unroll
    for (int j = 0; j < 4; ++j) { const int n = (lane >> 3) + 8 * j; const LAS float* s = scr + (8 * c) * 33 + n;
        u32x4 o; o.x = pk2(s[0 * 33], s[1 * 33]); o.y = pk2(s[2 * 33], s[3 * 33]); o.z = pk2(s[4 * 33], s[5 * 33]); o.w = pk2(s[6 * 33], s[7 * 33]);
        *(u32x4*)(WT + (size_t)(n0 + n) * K + k0 + 8 * c) = o;
        if (FOLD) { float a = (bflo(o.x) + bfhi(o.x)) + (bflo(o.y) + bfhi(o.y)) + (bflo(o.z) + bfhi(o.z)) + (bflo(o.w) + bfhi(o.w));
            a += __shfl_xor(a, 1); a += __shfl_xor(a, 2); a += __shfl_xor(a, 4);
            if (c == 0) __hip_atomic_fetch_add(cs + n0 + n, a, __ATOMIC_RELAXED, __HIP_MEMORY_SCOPE_AGENT); } }
    asm volatile("s_waitcnt lgkmcnt(0)" ::: "memory");
}

constexpr int NQ = 2, QW = 16 * NQ, VROW = 144;
#define MFMA16(a, b, c) __builtin_amdgcn_mfma_f32_16x16x32_bf16((a), (b), (c), 0, 0, 0)
__device__ __forceinline__ bf16x8 ldg8(const bf16_t* p) { return *(const bf16x8*)p; }
__device__ __forceinline__ s16x4 vtr(const LAS char* p) { return __builtin_bit_cast(s16x4, __builtin_amdgcn_ds_read_tr16_b64_v4i16((LAS s16x4*)p)); }

__device__ __forceinline__ void load_kfrag(bf16x8 (&kf)[2][2], const bf16_t* Kh, int ld, int tok0, int tok1, int g) {
    const bf16_t* p0 = Kh + (size_t)tok0 * ld + 8 * g; const bf16_t* p1 = Kh + (size_t)tok1 * ld + 8 * g;
    kf[0][0] = ldg8(p0); kf[0][1] = ldg8(p0 + 32); kf[1][0] = ldg8(p1); kf[1][1] = ldg8(p1 + 32);
}
__device__ __forceinline__ void load_vraw(u32x4 (&vr)[4], const bf16_t* Vh, int ld, const int (&vtok)[4], int lane) {
#pragma unroll
    for (int i = 0; i < 4; ++i) vr[i] = *(const u32x4*)(Vh + (size_t)vtok[i] * ld + 8 * (lane & 7));
}
__device__ __forceinline__ void stage_v(LAS char* vst, const u32x4 (&vr)[4], int lane) {
    asm volatile("" ::: "memory");
#pragma unroll
    for (int i = 0; i < 4; ++i) *(LAS u32x4*)(vst + ((lane >> 3) + 8 * i) * VROW + (lane & 7) * 16) = vr[i];
    asm volatile("" ::: "memory");
}
__device__ __forceinline__ void read_vfrag(bf16x8 (&vf)[4], const LAS char* vst, int lane) {
    const int g = lane >> 4, i16 = lane & 15, q = i16 >> 2, p = i16 & 3;
    const LAS char* base = vst + (4 * g + q) * VROW + 8 * p;
#pragma unroll
    for (int dt = 0; dt < 4; ++dt) { const s16x4 lo = vtr(base + 32 * dt), hi = vtr(base + 16 * VROW + 32 * dt);
        vf[dt] = (bf16x8){lo[0], lo[1], lo[2], lo[3], hi[0], hi[1], hi[2], hi[3]}; }
    asm volatile("" ::: "memory");
}
__device__ __forceinline__ void qk_tiles(f32x4& s0, f32x4& s1, const bf16x8 (&kf)[2][2], const bf16x8 (&qf)[2]) {
    const f32x4 z = {0.f, 0.f, 0.f, 0.f};
    s0 = MFMA16(kf[0][0], qf[0], z); s0 = MFMA16(kf[0][1], qf[1], s0);
    s1 = MFMA16(kf[1][0], qf[0], z); s1 = MFMA16(kf[1][1], qf[1], s1);
}
__device__ __forceinline__ bf16x8 pack_p(const f32x4& p0, const f32x4& p1) {
    u32x4 w; w.x = pk2(p0[0], p0[1]); w.y = pk2(p0[2], p0[3]); w.z = pk2(p1[0], p1[1]); w.w = pk2(p1[2], p1[3]);
    return __builtin_bit_cast(bf16x8, w);
}
__device__ __forceinline__ void softmax_pv(f32x4 s0, f32x4 s1, float& m, float& l, f32x4 (&o)[4], const bf16x8 (&vf)[4]) {
    float mx = fmaxf(fmaxf(fmaxf(s0[0], s0[1]), fmaxf(s0[2], s0[3])), fmaxf(fmaxf(s1[0], s1[1]), fmaxf(s1[2], s1[3])));
    mx = fmaxf(mx, __shfl_xor(mx, 16)); mx = fmaxf(mx, __shfl_xor(mx, 32));
    const float mn = fmaxf(m, mx), al = fexp2(m - mn); m = mn;
    f32x4 p0, p1;
#pragma unroll
    for (int e = 0; e < 4; ++e) { p0[e] = fexp2(s0[e] - mn); p1[e] = fexp2(s1[e] - mn); }
    l = l * al + ((p0[0] + p0[1]) + (p0[2] + p0[3])) + ((p1[0] + p1[1]) + (p1[2] + p1[3]));
    const bf16x8 pf = pack_p(p0, p1);
#pragma unroll
    for (int dt = 0; dt < 4; ++dt) { o[dt] = o[dt] * al; o[dt] = MFMA16(vf[dt], pf, o[dt]); }
}
__device__ __forceinline__ void store_gated(const f32x4 (&o)[4], float inv, const bf16_t* zrow, bf16_t* yrow, int g) {
#pragma unroll
    for (int dt = 0; dt < 4; ++dt) { const u32x2 zz = *(const u32x2*)(zrow + 16 * dt + 4 * g);
        u32x2 w; w.x = pk2(o[dt][0] * inv * bflo(zz.x), o[dt][1] * inv * bfhi(zz.x)); w.y = pk2(o[dt][2] * inv * bflo(zz.y), o[dt][3] * inv * bfhi(zz.y));
        *(u32x2*)(yrow + 16 * dt + 4 * g) = w; }
}

__device__ __forceinline__ void sb_unit(const bf16_t* QKV, bf16_t* YG, int b, int h, int t0, LAS char* vst, int lane) {
    constexpr int ld = 4096;
    const int g = lane >> 4, ql = lane & 15;
    const bf16_t* Qh = QKV + h * 64; const bf16_t* Kh = QKV + 1024 + h * 64; const bf16_t* Vh = QKV + 2048 + h * 64; const bf16_t* Zh = QKV + 3072 + h * 64;
    const int rb = b * SEQ;
    bf16x8 qf[NQ][2]; f32x4 o[NQ][4]; float carry[NQ];
#pragma unroll
    for (int nq = 0; nq < NQ; ++nq) { const bf16_t* qp = Qh + (size_t)(rb + t0 + 16 * nq + ql) * ld + 8 * g; qf[nq][0] = ldg8(qp); qf[nq][1] = ldg8(qp + 32); carry[nq] = 0.f;
#pragma unroll
        for (int dt = 0; dt < 4; ++dt) o[nq][dt] = (f32x4){0.f, 0.f, 0.f, 0.f}; }
    bf16x8 kfn[2][2]; u32x4 vrn[4];
    { const int kb = t0 + QW - 32; int vt[4];
#pragma unroll
      for (int i = 0; i < 4; ++i) vt[i] = rb + kb + (lane >> 3) + 8 * i;
      load_kfrag(kfn, Kh, ld, rb + kb + ql, rb + kb + 16 + ql, g); load_vraw(vrn, Vh, ld, vt, lane); }
    for (int kb = t0 + QW - 32; kb >= 0; kb -= 32) {
        bf16x8 kf[2][2]; bf16x8 vf[4];
#pragma unroll
        for (int a = 0; a < 2; ++a)
#pragma unroll
            for (int c = 0; c < 2; ++c) kf[a][c] = kfn[a][c];
        stage_v(vst, vrn, lane);
        if (kb >= 32) { const int kn = kb - 32; int vt[4];
#pragma unroll
            for (int i = 0; i < 4; ++i) vt[i] = rb + kn + (lane >> 3) + 8 * i;
            load_kfrag(kfn, Kh, ld, rb + kn + ql, rb + kn + 16 + ql, g); load_vraw(vrn, Vh, ld, vt, lane); }
        read_vfrag(vf, vst, lane);
        bool alldone = true;
#pragma unroll
        for (int nq = 0; nq < NQ; ++nq) {
            const int t = t0 + 16 * nq + ql;
            if (kb >= t0 + 16 * nq + 16) continue;
            f32x4 z[2]; qk_tiles(z[0], z[1], kf, qf[nq]);
            f32x4 L[2], lb[2]; bool valid[2][4];
#pragma unroll
            for (int T = 0; T < 2; ++T)
#pragma unroll
                for (int e = 0; e < 4; ++e) { const float zz = z[T][e]; const int key = kb + 16 * T + 4 * g + e; valid[T][e] = key < t;
                    const float sp = fmaxf(zz, 0.f) + LN2F * flog2(1.f + fexp2(-LOG2E * fabsf(zz)));
                    L[T][e] = valid[T][e] ? -sp : 0.f; lb[T][e] = zz - sp; }
            float ex[2][4], G[2], TT[2];
#pragma unroll
            for (int T = 0; T < 2; ++T) { ex[T][3] = 0.f; ex[T][2] = L[T][3]; ex[T][1] = L[T][3] + L[T][2]; ex[T][0] = ex[T][1] + L[T][1]; const float tot = ex[T][0] + L[T][0];
                const float a1 = __shfl_down(tot, 16), a2 = __shfl_down(tot, 32), a3 = __shfl_down(tot, 48);
                G[T] = (g < 3 ? a1 : 0.f) + (g < 2 ? a2 : 0.f) + (g < 1 ? a3 : 0.f);
                TT[T] = __shfl(G[T] + tot, ql); }
            f32x4 p[2];
#pragma unroll
            for (int e = 0; e < 4; ++e) { const float b1 = carry[nq] + G[1] + ex[1][e], b0 = carry[nq] + TT[1] + G[0] + ex[0][e];
                p[1][e] = valid[1][e] ? fexp2(LOG2E * (lb[1][e] + b1)) : 0.f; p[0][e] = valid[0][e] ? fexp2(LOG2E * (lb[0][e] + b0)) : 0.f; }
            carry[nq] += TT[1] + TT[0];
            const bf16x8 pf = pack_p(p[0], p[1]);
#pragma unroll
            for (int dt = 0; dt < 4; ++dt) o[nq][dt] = MFMA16(vf[dt], pf, o[nq][dt]);
        }
#pragma unroll
        for (int nq = 0; nq < NQ; ++nq) alldone = alldone && (carry[nq] < -110.f);
        if (__all(alldone)) break;
    }
#pragma unroll
    for (int nq = 0; nq < NQ; ++nq) { const size_t row = (size_t)(rb + t0 + 16 * nq + ql); store_gated(o[nq], 1.f, Zh + row * ld, YG + row * DM + h * 64, g); }
}

template <int MODE>
__device__ __forceinline__ void band_unit(const bf16_t* Qh, const bf16_t* Kh, const bf16_t* Vh, int ld, int rowbase, int dil, int L, int i0, int max_back, float sink2, bool has_sink,
                                          const bf16_t* Zh, bf16_t* Yh, int yld, size_t yrow_off, float* lse, int h, LAS char* vst, int lane) {
    const int g = lane >> 4, ql = lane & 15;
    bf16x8 qf[NQ][2]; f32x4 o[NQ][4]; float m[NQ], l[NQ];
#pragma unroll
    for (int nq = 0; nq < NQ; ++nq) { const bf16_t* qp = Qh + (size_t)(rowbase + (i0 + 16 * nq + ql) * dil) * ld + 8 * g; qf[nq][0] = ldg8(qp); qf[nq][1] = ldg8(qp + 32);
        m[nq] = has_sink ? sink2 : -1e30f; l[nq] = (has_sink && g == 0) ? 1.f : 0.f;
#pragma unroll
        for (int dt = 0; dt < 4; ++dt) o[nq][dt] = (f32x4){0.f, 0.f, 0.f, 0.f}; }
    int kstart = i0 - 128; if (kstart < 0) kstart = 0;
    bf16x8 kfn[2][2]; u32x4 vrn[4];
#define BAND_PREFETCH(kb_) do { const int kb__ = (kb_); int vt[4]; \
        _Pragma("unroll") for (int i = 0; i < 4; ++i) { int kk = kb__ + (lane >> 3) + 8 * i; kk = kk > L - 1 ? L - 1 : kk; vt[i] = rowbase + kk * dil; } \
        int k0 = kb__ + ql, k1 = kb__ + 16 + ql; k0 = k0 > L - 1 ? L - 1 : k0; k1 = k1 > L - 1 ? L - 1 : k1; \
        load_kfrag(kfn, Kh, ld, rowbase + k0 * dil, rowbase + k1 * dil, g); load_vraw(vrn, Vh, ld, vt, lane); } while (0)
    BAND_PREFETCH(kstart);
    for (int kb = kstart; kb < i0 + QW; kb += 32) {
        bf16x8 kf[2][2]; bf16x8 vf[4];
#pragma unroll
        for (int a = 0; a < 2; ++a)
#pragma unroll
            for (int c = 0; c < 2; ++c) kf[a][c] = kfn[a][c];
        stage_v(vst, vrn, lane);
        if (kb + 32 < i0 + QW) BAND_PREFETCH(kb + 32);
        read_vfrag(vf, vst, lane);
#pragma unroll
        for (int nq = 0; nq < NQ; ++nq) {
            const int qlo = i0 + 16 * nq;
            if (kb > qlo + 15 || kb + 31 < qlo - max_back) continue;
            const int qi = qlo + ql;
            f32x4 s[2]; qk_tiles(s[0], s[1], kf, qf[nq]);
#pragma unroll
            for (int T = 0; T < 2; ++T)
#pragma unroll
                for (int e = 0; e < 4; ++e) { const int dist = qi - (kb + 16 * T + 4 * g + e); s[T][e] = (dist >= 0 && dist <= max_back) ? s[T][e] * LOG2E : -__builtin_inff(); }
            softmax_pv(s[0], s[1], m[nq], l[nq], o[nq], vf);
        }
    }
#undef BAND_PREFETCH
#pragma unroll
    for (int nq = 0; nq < NQ; ++nq) {
        float lt = l[nq]; lt += __shfl_xor(lt, 16); lt += __shfl_xor(lt, 32);
        const float inv = 1.f / lt; const int tok = rowbase + (i0 + 16 * nq + ql) * dil;
        if (MODE == 0) store_gated(o[nq], inv, Zh + (size_t)tok * ld, Yh + ((size_t)tok + yrow_off) * yld, g);
        else {
            bf16_t* op = Yh + (size_t)tok * yld;
#pragma unroll
            for (int dt = 0; dt < 4; ++dt) { u32x2 w; w.x = pk2(o[nq][dt][0] * inv, o[nq][dt][1] * inv); w.y = pk2(o[nq][dt][2] * inv, o[nq][dt][3] * inv); *(u32x2*)(op + 16 * dt + 4 * g) = w; }
            if (g == 0) lse[(size_t)tok * 16 + h] = (m[nq] + flog2(lt)) * LN2F;
        }
    }
}

constexpr int BL_KIMG = 0, BL_VIMG = 384 * VROW;
template <int MODE>
__device__ __forceinline__ void band_lds_phase(bf16_t* QKV, bf16_t* YG, float* LSE, const float* sinks, LAS unsigned char* lds, int G, int tid) {
    const int lane = tid & 63, wave = __builtin_amdgcn_readfirstlane(tid >> 6), g = lane >> 4, ql = lane & 15;
    LAS char* Kimg = (LAS char*)lds + BL_KIMG; LAS char* Vimg = (LAS char*)lds + BL_VIMG;
    constexpr int NUNITS = MODE == 0 ? NBATCH * 4 * (SEQ / 64) : 3 * 1024;
    constexpr int ld = MODE == 0 ? 2560 : 10240, QSPAN = MODE == 0 ? 64 : 256, max_back = MODE == 0 ? 127 : 128;
    u32x4 pre[12]; bf16x8 qn[2][2];
#define BL_DECODE(U_) \
    int d_dil, d_i0, d_rowbase, d_h0; const bf16_t* d_K; \
    if (MODE == 0) { const int chunk = (U_) & 127, bk = (U_) >> 7; d_dil = 1; d_i0 = chunk * 64; d_rowbase = (bk >> 2) * SEQ; d_h0 = (bk & 3) * 4; d_K = QKV + 1024 + (bk & 3) * 64; } \
    else { const int grp = (U_) >> 10, v = (U_) & 1023; d_dil = grp == 0 ? 1 : (grp == 1 ? 4 : 16); const int nch = (SEQ / 256) / d_dil; const int chunk = v % nch, rest = v / nch; d_h0 = rest & 15; const int s = rest >> 4; \
        d_rowbase = (s / d_dil) * SEQ + (s % d_dil); d_i0 = chunk * 256; d_K = QKV + (size_t)(3 * grp + 1) * 1024 + d_h0 * 64; } \
    const int d_kw0 = d_i0 >= 128 ? d_i0 - 128 : 0, d_nrows = d_i0 + QSPAN - d_kw0; const bf16_t* d_V = d_K + (MODE == 0 ? 256 : 1024);
#define BL_LOAD(U_) do { BL_DECODE(U_) \
        const unsigned voff = (unsigned)(((tid >> 3) * d_dil * ld + 8 * (tid & 7)) * 2); const size_t cstride = (size_t)64 * d_dil * ld * 2; \
        const char* kbp = (const char*)(d_K + (size_t)(d_rowbase + d_kw0 * d_dil) * ld); const char* vbp = (const char*)(d_V + (size_t)(d_rowbase + d_kw0 * d_dil) * ld); \
        _Pragma("unroll") for (int c = 0; c < 6; ++c) { if (64 * c < d_nrows) { pre[c] = *(const u32x4*)(kbp + c * cstride + voff); pre[6 + c] = *(const u32x4*)(vbp + c * cstride + voff); } } \
        { const int h_ = MODE == 0 ? d_h0 + (wave & 3) : d_h0, q0_ = MODE == 0 ? d_i0 + 32 * (wave >> 2) : d_i0 + 32 * wave; const bf16_t* Qh_ = MODE == 0 ? QKV + h_ * 64 : d_K - 1024; \
          _Pragma("unroll") for (int nq = 0; nq < 2; ++nq) { const bf16_t* qp = Qh_ + (size_t)(d_rowbase + (q0_ + 16 * nq + ql) * d_dil) * ld + 8 * g; qn[nq][0] = ldg8(qp); qn[nq][1] = ldg8(qp + 32); } } } while (0)
    int U = (int)blockIdx.x;
    if (U < NUNITS) BL_LOAD(U);
    for (; U < NUNITS; U += G) {
        BL_DECODE(U)
        __syncthreads();
        { LAS char* kw = Kimg + (tid >> 3) * VROW + (tid & 7) * 16; LAS char* vw = Vimg + (tid >> 3) * VROW + (tid & 7) * 16;
#pragma unroll
          for (int c = 0; c < 6; ++c) { if (64 * c < d_nrows) { *(LAS u32x4*)(kw + c * 64 * VROW) = pre[c]; *(LAS u32x4*)(vw + c * 64 * VROW) = pre[6 + c]; } } }
        __syncthreads();
        bf16x8 qf[2][2];
#pragma unroll
        for (int nq = 0; nq < 2; ++nq) { qf[nq][0] = qn[nq][0]; qf[nq][1] = qn[nq][1]; }
        if (U + G < NUNITS) BL_LOAD(U + G);
        const int h = MODE == 0 ? d_h0 + (wave & 3) : d_h0, q0 = MODE == 0 ? d_i0 + 32 * (wave >> 2) : d_i0 + 32 * wave;
        const bf16_t* Qh = MODE == 0 ? QKV + h * 64 : d_K - 1024;
        f32x4 o[2][4]; float m[2], l[2];
        const float sink2 = MODE == 0 ? sinks[h] * LOG2E : 0.f;
#pragma unroll
        for (int nq = 0; nq < 2; ++nq) {
            m[nq] = MODE == 0 ? sink2 : -1e30f; l[nq] = (MODE == 0 && g == 0) ? 1.f : 0.f;
#pragma unroll
            for (int dt = 0; dt < 4; ++dt) o[nq][dt] = (f32x4){0.f, 0.f, 0.f, 0.f}; }
        const int kstart = q0 >= 128 ? q0 - 128 : 0;
        const int i16q = ql >> 2, i16p = ql & 3;
        for (int kb = kstart; kb < q0 + 32; kb += 32) {
            const int kr = kb - d_kw0;
            bf16x8 kf[2][2], vf[4];
#pragma unroll
            for (int T = 0; T < 2; ++T) { const LAS char* kp = Kimg + (kr + 16 * T + ql) * VROW + 16 * g; kf[T][0] = *(const LAS bf16x8*)kp; kf[T][1] = *(const LAS bf16x8*)(kp + 64); }
            { const LAS char* vb = Vimg + (kr + 4 * g + i16q) * VROW + 8 * i16p;
#pragma unroll
              for (int dt = 0; dt < 4; ++dt) { const s16x4 lo = vtr(vb + 32 * dt), hi = vtr(vb + 16 * VROW + 32 * dt); vf[dt] = (bf16x8){lo[0], lo[1], lo[2], lo[3], hi[0], hi[1], hi[2], hi[3]}; } }
#pragma unroll
            for (int nq = 0; nq < 2; ++nq) {
                const int qlo = q0 + 16 * nq;
                if (kb > qlo + 15 || kb + 31 < qlo - max_back) continue;
                const int qi = qlo + ql;
                f32x4 s[2]; qk_tiles(s[0], s[1], kf, qf[nq]);
#pragma unroll
                for (int T = 0; T < 2; ++T)
#pragma unroll
                    for (int e = 0; e < 4; ++e) { const int dist = qi - (kb + 16 * T + 4 * g + e); s[T][e] = (dist >= 0 && dist <= max_back) ? s[T][e] * LOG2E : -__builtin_inff(); }
                softmax_pv(s[0], s[1], m[nq], l[nq], o[nq], vf);
            }
        }
#pragma unroll
        for (int nq = 0; nq < 2; ++nq) {
            float lt = l[nq]; lt += __shfl_xor(lt, 16); lt += __shfl_xor(lt, 32);
            const float inv = 1.f / lt; const int tok = d_rowbase + (q0 + 16 * nq + ql) * d_dil;
            if (MODE == 0) store_gated(o[nq], inv, QKV + (size_t)tok * ld + 1536 + h * 64, YG + (size_t)tok * DM + h * 64, g);
            else {
                bf16_t* op = (bf16_t*)Qh + (size_t)tok * ld;
#pragma unroll
                for (int dt = 0; dt < 4; ++dt) { u32x2 w; w.x = pk2(o[nq][dt][0] * inv, o[nq][dt][1] * inv); w.y = pk2(o[nq][dt][2] * inv, o[nq][dt][3] * inv); *(u32x2*)(op + 16 * dt + 4 * g) = w; }
                if (g == 0) LSE[(size_t)((U >> 10) * 16384 + tok) * 16 + h] = (m[nq] + flog2(lt)) * LN2F;
            }
        }
    }
    __syncthreads();
#undef BL_DECODE
#undef BL_LOAD
}

__device__ __forceinline__ void moba_own_unit(const bf16_t* QKV, const bf16_t* KMH, const bf16_t* KML, bf16_t* YG, float* LSE0, unsigned* SEL, int b, int h, int t0, LAS char* vst, int lane) {
    constexpr int ld = 4096;
    const int g = lane >> 4, ql = lane & 15;
    const bf16_t* Qh = QKV + h * 64; const bf16_t* Kh = QKV + 1024 + h * 64; const bf16_t* Vh = QKV + 2048 + h * 64;
    const int rb = b * SEQ, QB = t0 >> 8;
    bf16x8 qf[NQ][2]; f32x4 o[NQ][4]; float m[NQ], l[NQ];
#pragma unroll
    for (int nq = 0; nq < NQ; ++nq) { const bf16_t* qp = Qh + (size_t)(rb + t0 + 16 * nq + ql) * ld + 8 * g; qf[nq][0] = ldg8(qp); qf[nq][1] = ldg8(qp + 32); m[nq] = -1e30f; l[nq] = 0.f;
#pragma unroll
        for (int dt = 0; dt < 4; ++dt) o[nq][dt] = (f32x4){0.f, 0.f, 0.f, 0.f}; }
    {
        const bf16_t* kmh = KMH + (size_t)((b * 16 + h) * 32) * 64; const bf16_t* kml = KML + (size_t)((b * 16 + h) * 32) * 64;
        bf16x8 ah[2][2], al[2][2];
#pragma unroll
        for (int T = 0; T < 2; ++T)
#pragma unroll
            for (int ks = 0; ks < 2; ++ks) { ah[T][ks] = ldg8(kmh + (16 * T + ql) * 64 + 32 * ks + 8 * g); al[T][ks] = ldg8(kml + (16 * T + ql) * 64 + 32 * ks + 8 * g); }
#pragma unroll
        for (int nq = 0; nq < NQ; ++nq) {
            f32x4 gt[2];
#pragma unroll
            for (int T = 0; T < 2; ++T) { f32x4 a = {0.f, 0.f, 0.f, 0.f}; a = MFMA16(al[T][0], qf[nq][0], a); a = MFMA16(al[T][1], qf[nq][1], a); a = MFMA16(ah[T][0], qf[nq][0], a); a = MFMA16(ah[T][1], qf[nq][1], a); gt[T] = a; }
            float gv[8];
#pragma unroll
            for (int T = 0; T < 2; ++T)
#pragma unroll
                for (int e = 0; e < 4; ++e) gv[4 * T + e] = (16 * T + 4 * g + e) < QB ? gt[T][e] : -__builtin_inff();
            unsigned s = 0u;
#pragma unroll
            for (int r = 0; r < 3; ++r) {
                float bv = -__builtin_inff(); int bi = 64;
#pragma unroll
                for (int c = 0; c < 8; ++c) { const int idx = 16 * (c >> 2) + 4 * g + (c & 3); if (gv[c] > bv) { bv = gv[c]; bi = idx; } }
#pragma unroll
                for (int off = 16; off < 64; off <<= 1) { const float ov = __shfl_xor(bv, off); const int oi = __shfl_xor(bi, off); if (ov > bv || (ov == bv && oi < bi)) { bv = ov; bi = oi; } }
                if (bi < 32) { s |= 1u << bi;
#pragma unroll
                    for (int c = 0; c < 8; ++c) { const int idx = 16 * (c >> 2) + 4 * g + (c & 3); if (idx == bi) gv[c] = -__builtin_inff(); } }
            }
            if (g == 0) SEL[(size_t)(b * 16 + h) * SEQ + t0 + 16 * nq + ql] = s;
        }
    }
    const int kend = t0 + QW;
    bf16x8 kfn[2][2]; u32x4 vrn[4];
#define MOBA_PREFETCH(kb_) do { const int kb__ = rb + (kb_); int vt[4]; \
        _Pragma("unroll") for (int i = 0; i < 4; ++i) vt[i] = kb__ + (lane >> 3) + 8 * i; \
        load_kfrag(kfn, Kh, ld, kb__ + ql, kb__ + 16 + ql, g); load_vraw(vrn, Vh, ld, vt, lane); } while (0)
    MOBA_PREFETCH(QB * 256);
    for (int kb = QB * 256; kb < kend; kb += 32) {
        bf16x8 kf[2][2]; bf16x8 vf[4];
#pragma unroll
        for (int a = 0; a < 2; ++a)
#pragma unroll
            for (int c = 0; c < 2; ++c) kf[a][c] = kfn[a][c];
        stage_v(vst, vrn, lane);
        if (kb + 32 < kend) MOBA_PREFETCH(kb + 32);
        read_vfrag(vf, vst, lane);
#pragma unroll
        for (int nq = 0; nq < NQ; ++nq) {
            if (kb > t0 + 16 * nq + 15) continue;
            const int t = t0 + 16 * nq + ql;
            f32x4 s[2]; qk_tiles(s[0], s[1], kf, qf[nq]);
#pragma unroll
            for (int T = 0; T < 2; ++T)
#pragma unroll
                for (int e = 0; e < 4; ++e) { const int key = kb + 16 * T + 4 * g + e; s[T][e] = (key <= t) ? s[T][e] * LOG2E : -__builtin_inff(); }
            softmax_pv(s[0], s[1], m[nq], l[nq], o[nq], vf);
        }
    }
#undef MOBA_PREFETCH
#pragma unroll
    for (int nq = 0; nq < NQ; ++nq) { float lt = l[nq]; lt += __shfl_xor(lt, 16); lt += __shfl_xor(lt, 32);
        const float inv = 1.f / lt; const size_t row = (size_t)(rb + t0 + 16 * nq + ql); bf16_t* op = YG + row * DM + h * 64;
#pragma unroll
        for (int dt = 0; dt < 4; ++dt) { u32x2 w; w.x = pk2(o[nq][dt][0] * inv, o[nq][dt][1] * inv); w.y = pk2(o[nq][dt][2] * inv, o[nq][dt][3] * inv); *(u32x2*)(op + 16 * dt + 4 * g) = w; }
        if (g == 0) LSE0[row * 16 + h] = (m[nq] + flog2(lt)) * LN2F; }
}

constexpr int MR_KIMG = 0, MR_VIMG = 36864, MR_LIST = 73728, MR_CNT = 73728 + 32768;
__device__ __forceinline__ void moba_routed_unit(const bf16_t* QKV, const unsigned* SEL, bf16_t* YG, float* LSE0, bf16_t* PA, float* LSEA, bf16_t* PB, float* LSEB,
                                                 int b, int h, int j, LAS unsigned char* lds, int tid) {
    constexpr int ld = 4096;
    const int lane = tid & 63, wave = __builtin_amdgcn_readfirstlane(tid >> 6), g = lane >> 4, ql = lane & 15;
    LAS char* Kimg = (LAS char*)lds + MR_KIMG; LAS char* Vimg = (LAS char*)lds + MR_VIMG; LAS unsigned* list = (LAS unsigned*)(lds + MR_LIST); LAS unsigned* cnt = (LAS unsigned*)(lds + MR_CNT);
    __syncthreads();
    if (tid == 0) *cnt = 0u;
    const int rb = b * SEQ + j * 256;
#pragma unroll
    for (int i = 0; i < 4; ++i) { const int chunk = tid + 512 * i, row = chunk >> 3, c = chunk & 7; const bf16_t* src = QKV + (size_t)(rb + row) * ld + h * 64 + 8 * c;
        *(LAS u32x4*)(Kimg + row * VROW + c * 16) = *(const u32x4*)(src + 1024); *(LAS u32x4*)(Vimg + row * VROW + c * 16) = *(const u32x4*)(src + 2048); }
    __syncthreads();
    const unsigned* selp = SEL + (size_t)(b * 16 + h) * SEQ;
    {
        unsigned mks[16];
#pragma unroll
        for (int i = 0; i < 16; ++i) { const int tb = (j + 1) * 256 + wave * 64 + 512 * i; mks[i] = tb < SEQ ? selp[tb + lane] : 0u; }
#pragma unroll
        for (int i = 0; i < 16; ++i) { const int tb = (j + 1) * 256 + wave * 64 + 512 * i; if (tb >= SEQ) break;
            const unsigned mk = mks[i]; const bool hit = (mk >> j) & 1u;
            const unsigned long long bal = __ballot(hit); const unsigned nh = (unsigned)__popcll(bal);
            unsigned base = 0u; if (lane == 0 && nh) base = __hip_atomic_fetch_add(cnt, nh, __ATOMIC_RELAXED, __HIP_MEMORY_SCOPE_WORKGROUP);
            base = (unsigned)__builtin_amdgcn_readfirstlane((int)base);
            if (hit) { const unsigned rank = __builtin_popcount(mk & ((1u << j) - 1u)); const unsigned pos = base + (unsigned)__popcll(bal & ((1ull << lane) - 1ull)); list[pos] = (unsigned)(tb + lane) | (rank << 16); } }
    }
    __syncthreads();
    const int n = (int)*cnt, ntiles = (n + 15) >> 4;
    unsigned e_n = 0u; bool valid_n = false; bf16x8 q0n = {0, 0, 0, 0, 0, 0, 0, 0}, q1n = q0n; u32x2 ovn[4]; float oldn = 0.f;
#pragma unroll
    for (int dt = 0; dt < 4; ++dt) ovn[dt] = (u32x2){0u, 0u};
#define MR_FETCH(tile_) do { const int idx_ = 16 * (tile_) + ql; valid_n = idx_ < n; e_n = list[valid_n ? idx_ : n - 1]; const size_t row_ = (size_t)(b * SEQ + (int)(e_n & 0xffffu)); \
        const bf16_t* qp_ = QKV + row_ * ld + h * 64 + 8 * g; q0n = ldg8(qp_); q1n = ldg8(qp_ + 32); \
        if (valid_n && (e_n >> 16) == 0u) { oldn = LSE0[row_ * 16 + h]; const bf16_t* op_ = YG + row_ * DM + h * 64 + 4 * g; \
            _Pragma("unroll") for (int dt = 0; dt < 4; ++dt) ovn[dt] = *(const u32x2*)(op_ + 16 * dt); } } while (0)
    if (wave < ntiles) MR_FETCH(wave);
    for (int tile = wave; tile < ntiles; tile += NWAVES) {
        const bool valid = valid_n; const unsigned e = e_n; const int t = (int)(e & 0xffffu), rank = (int)(e >> 16);
        const size_t row = (size_t)(b * SEQ + t);
        const bf16x8 q0 = q0n, q1 = q1n; const float old = oldn; u32x2 ov[4];
#pragma unroll
        for (int dt = 0; dt < 4; ++dt) ov[dt] = ovn[dt];
        if (tile + NWAVES < ntiles) MR_FETCH(tile + NWAVES);
        f32x4 s[16]; float mx = -1e30f;
#pragma unroll
        for (int T = 0; T < 16; ++T) { const LAS char* kp = Kimg + (16 * T + ql) * VROW + 16 * g; const bf16x8 a0 = *(const LAS bf16x8*)kp, a1 = *(const LAS bf16x8*)(kp + 64);
            f32x4 a = {0.f, 0.f, 0.f, 0.f}; a = MFMA16(a0, q0, a); a = MFMA16(a1, q1, a); s[T] = a * LOG2E; mx = fmaxf(mx, fmaxf(fmaxf(s[T][0], s[T][1]), fmaxf(s[T][2], s[T][3]))); }
        mx = fmaxf(mx, __shfl_xor(mx, 16)); mx = fmaxf(mx, __shfl_xor(mx, 32));
        float l = 0.f; f32x4 o[4];
#pragma unroll
        for (int dt = 0; dt < 4; ++dt) o[dt] = (f32x4){0.f, 0.f, 0.f, 0.f};
        const int i16q = ql >> 2, i16p = ql & 3;
#pragma unroll
        for (int k8 = 0; k8 < 8; ++k8) { f32x4 p0, p1;
#pragma unroll
            for (int c = 0; c < 4; ++c) { p0[c] = fexp2(s[2 * k8][c] - mx); p1[c] = fexp2(s[2 * k8 + 1][c] - mx); }
            l += ((p0[0] + p0[1]) + (p0[2] + p0[3])) + ((p1[0] + p1[1]) + (p1[2] + p1[3]));
            const bf16x8 pf = pack_p(p0, p1);
            const LAS char* vb = Vimg + (32 * k8 + 4 * g + i16q) * VROW + 8 * i16p;
#pragma unroll
            for (int dt = 0; dt < 4; ++dt) { const s16x4 lo = vtr(vb + 32 * dt), hi = vtr(vb + 16 * VROW + 32 * dt);
                const bf16x8 vf = (bf16x8){lo[0], lo[1], lo[2], lo[3], hi[0], hi[1], hi[2], hi[3]}; o[dt] = MFMA16(vf, pf, o[dt]); } }
        l += __shfl_xor(l, 16); l += __shfl_xor(l, 32);
        const float inv = 1.f / l, lse = (mx + flog2(l)) * LN2F;
        if (valid) {
            if (rank == 0) {
                const float mm = fmaxf(old, lse); const float wo = fexp2((old - mm) * LOG2E), wn = fexp2((lse - mm) * LOG2E); const float i2 = 1.f / (wo + wn);
                const float co = wo * i2, cn = wn * i2 * inv; bf16_t* op = YG + row * DM + h * 64;
#pragma unroll
                for (int dt = 0; dt < 4; ++dt) {
                    u32x2 w; w.x = pk2(co * bflo(ov[dt].x) + cn * o[dt][0], co * bfhi(ov[dt].x) + cn * o[dt][1]); w.y = pk2(co * bflo(ov[dt].y) + cn * o[dt][2], co * bfhi(ov[dt].y) + cn * o[dt][3]); *(u32x2*)(op + 16 * dt + 4 * g) = w; }
                if (g == 0) LSE0[row * 16 + h] = mm + flog2(wo + wn) * LN2F;
            } else {
                bf16_t* op = (rank == 1 ? PA : PB) + row * DM + h * 64; float* lp = (rank == 1 ? LSEA : LSEB);
#pragma unroll
                for (int dt = 0; dt < 4; ++dt) { u32x2 w; w.x = pk2(o[dt][0] * inv, o[dt][1] * inv); w.y = pk2(o[dt][2] * inv, o[dt][3] * inv); *(u32x2*)(op + 16 * dt + 4 * g) = w; }
                if (g == 0) lp[row * 16 + h] = lse;
            }
        }
    }
#undef MR_FETCH
}

#define XB_TMO      128
#define XB_XCNT(j)  (256  + 64 * (j))
#define XB_XSUB(j)  (1280 + 64 * (j))
#define XB_XGEN(j)  (2304 + 64 * (j))
#define XB_TOP      3328
#define XB_TOPGEN   3392
#define XCD_BAR_WORDS 3456
#define XB_SPIN_CAP (1u << 18)

__device__ __forceinline__ unsigned xb_ld(unsigned* p)              { return __hip_atomic_load(p, __ATOMIC_RELAXED, __HIP_MEMORY_SCOPE_AGENT); }
__device__ __forceinline__ unsigned xb_add(unsigned* p, unsigned v) { return __hip_atomic_fetch_add(p, v, __ATOMIC_RELAXED, __HIP_MEMORY_SCOPE_AGENT); }
__device__ __forceinline__ unsigned xb_xcc_id() { return (unsigned)__builtin_amdgcn_s_getreg((3 << 11) | 20) & 0xFu; }
#define XB_SPIN(cond, bar) do { unsigned _sp = 0; while (cond) { __builtin_amdgcn_s_sleep(1); \
    if ((++_sp & 255u) == 0u) { if (xb_ld(&(bar)[XB_TMO])) break; if (_sp > XB_SPIN_CAP) { atomicAdd(&(bar)[XB_TMO], 1u); break; } } } } while (0)

struct XcdBarrier {
    unsigned* bar; unsigned x;
    volatile LAS unsigned* st;
};

__device__ __forceinline__ XcdBarrier xcd_barrier_post(unsigned* bar, volatile LAS unsigned* st) {
    XcdBarrier b; b.bar = bar; b.x = xb_xcc_id(); b.st = st;
    if (threadIdx.x == 0) (void)xb_add(&bar[XB_XCNT(b.x)], 1u);
    return b;
}
__device__ __forceinline__ void xcd_barrier_complete(unsigned* bar, unsigned x, unsigned& nloc, unsigned& nx) {
    const unsigned G = gridDim.x * gridDim.y * gridDim.z;
    unsigned sum, cnt, mine, sp = 0u;
    for (;;) {
        sum = 0u; cnt = 0u; mine = 0u;
#pragma unroll
        for (unsigned j = 0; j < 16; ++j) { const unsigned c = xb_ld(&bar[XB_XCNT(j)]); sum += c; cnt += (c > 0u) ? 1u : 0u; mine = (j == x) ? c : mine; }
        if (sum == G) break;
        __builtin_amdgcn_s_sleep(1);
        if ((++sp & 255u) == 0u) { if (xb_ld(&bar[XB_TMO])) break; if (sp > XB_SPIN_CAP) { atomicAdd(&bar[XB_TMO], 1u); break; } }
    }
    nloc = mine > 0u ? mine : 1u; nx = cnt > 0u ? cnt : 1u;
}

__device__ __forceinline__ void xcd_barrier(const XcdBarrier& b) {
    asm volatile("s_waitcnt vmcnt(0)" ::: "memory");
    __syncthreads();
    if (threadIdx.x == 0) {
        unsigned* bar = b.bar;
        __builtin_amdgcn_s_waitcnt(0);
        unsigned nloc = b.st[0], nx = b.st[1];
        if (nloc == 0u) { xcd_barrier_complete(bar, b.x, nloc, nx); b.st[0] = nloc; b.st[1] = nx; }
        const unsigned old = xb_add(&bar[XB_XSUB(b.x)], 1u);
        const unsigned gen = old / nloc;
        if (old + 1u == (gen + 1u) * nloc) {
            __builtin_amdgcn_fence(__ATOMIC_RELEASE, "agent");
            asm volatile("s_waitcnt vmcnt(0)" ::: "memory");
            const unsigned og = xb_add(&bar[XB_TOP], 1u);
            const unsigned tg = og / nx;
            if (og + 1u == (tg + 1u) * nx) xb_add(&bar[XB_TOPGEN], 1u);
            else XB_SPIN(xb_ld(&bar[XB_TOPGEN]) == tg, bar);
            __builtin_amdgcn_fence(__ATOMIC_ACQUIRE, "agent");
            xb_add(&bar[XB_XGEN(b.x)], 1u);
            asm volatile("s_waitcnt vmcnt(0)" ::: "memory");
        } else {
            XB_SPIN(xb_ld(&bar[XB_XGEN(b.x)]) == gen, bar);
            __builtin_amdgcn_fence(__ATOMIC_ACQUIRE, "agent");
            asm volatile("s_waitcnt vmcnt(0)" ::: "memory");
        }
    }
    __syncthreads();
}

struct Args { const float* in[18]; float* out; unsigned char* ws; int ph_lo, ph_hi; };
constexpr int N_PHASES = 24;

__global__ void __launch_bounds__(NWAVES * 64, 2) hybrid_fwd(Args args) {
    extern __shared__ __attribute__((aligned(16))) unsigned char lds[];
    cg::grid_group grid = cg::this_grid();
    LAS unsigned char* ldsl = (LAS unsigned char*)lds;
    const int tid = threadIdx.x, lane = tid & 63, wave = __builtin_amdgcn_readfirstlane(tid >> 6);
    const int G = gridDim.x, gw = blockIdx.x * NWAVES + wave, NGW = G * NWAVES;
    unsigned char* ws = args.ws;
    float* rope = (float*)(ws + WS_ROPE);
    bf16_t* KMH = (bf16_t*)(ws + WS_KMH); bf16_t* KML = (bf16_t*)(ws + WS_KML); float* LSE0 = (float*)(ws + WS_LSE); float* LSEA = (float*)(ws + WS_LSE + 2 * MiB); float* LSEB = (float*)(ws + WS_LSE + 4 * MiB); unsigned* SEL = (unsigned*)(ws + WS_LSE + 6 * MiB);
    bf16_t* WIN[4] = {(bf16_t*)(ws + WS_WIN0), (bf16_t*)(ws + WS_WIN1), (bf16_t*)(ws + WS_WIN2), (bf16_t*)(ws + WS_WIN3)};
    bf16_t* WOUT = (bf16_t*)(ws + WS_WOUT);
    bf16_t* XN = (bf16_t*)(ws + WS_XN); bf16_t* YG = (bf16_t*)(ws + WS_YG); bf16_t* QKV = (bf16_t*)(ws + WS_QKV); bf16_t* PA = (bf16_t*)(ws + WS_QKV + 256 * MiB); bf16_t* PB = XN;
    float* X = args.out;
    LAS char* vst = (LAS char*)(ldsl + wave * 16384);
    const int lo = args.ph_lo, hi = args.ph_hi;
#define IN(k) (lo <= (k) && (k) < hi)
    if (tid < 64) ((LAS unsigned*)(ldsl + MISC_OFF))[tid] = 0u;
    __syncthreads();
    (void)xcd_barrier_post((unsigned*)(ws + WS_BAR), (volatile LAS unsigned*)(ldsl + MISC_OFF) + 8);
    int ph = 0;
#define PH_IF if (IN(ph))
#define PH_END do { if (IN(ph) && IN(ph + 1)) { if (ph == 0) grid.sync(); else { XcdBarrier bar_; { unsigned* bp_ = (unsigned*)(args.ws + WS_BAR); asm volatile("" : "+s"(bp_)); bar_.bar = bp_; } bar_.x = xb_xcc_id(); bar_.st = (volatile LAS unsigned*)(ldsl + MISC_OFF) + 8; xcd_barrier(bar_); } } ++ph; } while (0)

    PH_IF {
        LAS float* scr = (LAS float*)(ldsl + wave * 16384);
        const int n_in[4] = {4096, 4096, 2560, 10240}; const int w_in_idx[4] = {1, 5, 9, 14}; const int w_out_idx[4] = {2, 6, 11, 15};
#pragma unroll
        for (int mi = 0; mi < 8; ++mi) {
            const int N = mi < 4 ? n_in[mi] : 1024; const int items = 16 * (N / 32);
            const float* W = mi < 4 ? args.in[w_in_idx[mi]] : args.in[w_out_idx[mi - 4]];
            bf16_t* WT = mi < 4 ? WIN[mi] : WOUT + (size_t)(mi - 4) * 1024 * 1024;
            if (mi >= 1 && mi <= 3) { const int gi[4] = {0, 3, 7, 12}; const float* gp = args.in[gi[mi]]; const float* bp = args.in[gi[mi] + 1];
                float* cs = (float*)(ws + WS_CS) + (mi - 1) * CSLD; float* cb = (float*)(ws + WS_CB) + (mi - 1) * CSLD;
                for (int it = gw; it < items; it += NGW) transpose_item<true>(W, 1024, N, WT, scr, it, lane, gp, bp, cs, cb); }
            else for (int it = gw; it < items; it += NGW) transpose_item<false>(W, 1024, N, WT, scr, it, lane, nullptr, nullptr, nullptr, nullptr);
        }
        const int gt = blockIdx.x * (NWAVES * 64) + tid, NGT = G * NWAVES * 64;
        for (int idx = gt; idx < SEQ * 8; idx += NGT) { const int pos = idx >> 3, i = idx & 7;
            const float inv = (float)pow(500000.0, -(double)i / 8.0); const float ang = (float)pos * inv;
            double sn, cs; sincos((double)ang, &sn, &cs); rope[pos * 16 + i] = (float)cs; rope[pos * 16 + 8 + i] = (float)sn; }
        const float* x = args.in[0];
        for (size_t idx = gt; idx < (size_t)MTOK * DM / 8; idx += (size_t)NGT * 4) {
            f32x4 a[4], c[4];
#pragma unroll
            for (int r = 0; r < 4; ++r) { if (idx + (size_t)r * NGT < (size_t)MTOK * DM / 8) { a[r] = *(const f32x4*)(x + (idx + (size_t)r * NGT) * 8); c[r] = *(const f32x4*)(x + (idx + (size_t)r * NGT) * 8 + 4); } }
#pragma unroll
            for (int r = 0; r < 4; ++r) if (idx + (size_t)r * NGT < (size_t)MTOK * DM / 8) { u32x4 w; w.x = pk2(a[r][0], a[r][1]); w.y = pk2(a[r][2], a[r][3]); w.z = pk2(c[r][0], c[r][1]); w.w = pk2(c[r][2], c[r][3]); *(u32x4*)(XN + (idx + (size_t)r * NGT) * 8) = w; } }
    }
    PH_END;

#define GEMM_IN(layer_, A_, Mrows_, N_, rowoff_) do { pg8::Gemm gg{(A_), WIN[layer_], (Mrows_), (N_), DM}; pg8::StaticOrder S; S.init((Mrows_), (N_), G, (int)blockIdx.x); \
        pg8::EpiIn E{QKV, (N_), (layer_), rope, (layer_) == 0 ? nullptr : (const float*)(ws + WS_STATS) + (size_t)((layer_) - 1) * MTOK * 2, (const float*)(ws + WS_CS) + ((layer_) - 1) * CSLD, (const float*)(ws + WS_CB) + ((layer_) - 1) * CSLD, (rowoff_)}; \
        pg8::gemm_phase<pg8::EpiIn, pg8::StaticOrder, true, true>(ldsl, gg, S, E); } while (0)
#define GEMM_OUT(layer_, Xsrc_, gidx_) do { pg8::Gemm gg{YG, WOUT + (size_t)(layer_) * 1024 * 1024, MTOK, DM, DM}; pg8::StaticOrder S; S.init(MTOK, DM, G, (int)blockIdx.x); \
        pg8::EpiOut E{(Xsrc_), X, DN_ALPHA, (layer_) == 0 ? nullptr : (const float*)(ws + WS_STATS) + (size_t)((layer_) - 1) * MTOK * 2, args.in[gidx_], args.in[(gidx_) + 1], \
                      (layer_) == 3 ? nullptr : (float*)(ws + WS_STATS) + (size_t)(layer_) * MTOK * 2, XN}; \
        pg8::gemm_phase<pg8::EpiOut, pg8::StaticOrder, true, true>(ldsl, gg, S, E); } while (0)
#define LN_PHASE(gidx_, bidx_, write_xn_) do { const float* gp = args.in[gidx_]; const float* bp = args.in[bidx_]; \
        f32x4 gv[4], bv[4]; _Pragma("unroll") for (int jj = 0; jj < 4; ++jj) { gv[jj] = *(const f32x4*)(gp + 4 * lane + 256 * jj); bv[jj] = *(const f32x4*)(bp + 4 * lane + 256 * jj); } \
        for (int r = gw; r < MTOK; r += NGW) { float* xr = X + (size_t)r * DM + 4 * lane; f32x4 v[4]; float s = 0.f; \
            _Pragma("unroll") for (int jj = 0; jj < 4; ++jj) { v[jj] = *(const f32x4*)(xr + 256 * jj); s += (v[jj][0] + v[jj][1]) + (v[jj][2] + v[jj][3]); } \
            const float mean = wave_sum(s) * (1.f / DM); float s2 = 0.f; \
            _Pragma("unroll") for (int jj = 0; jj < 4; ++jj) { v[jj] = v[jj] - mean; s2 += (v[jj][0] * v[jj][0] + v[jj][1] * v[jj][1]) + (v[jj][2] * v[jj][2] + v[jj][3] * v[jj][3]); } \
            const float rstd = 1.f / sqrtf(wave_sum(s2) * (1.f / DM) + LN_EPS); \
            _Pragma("unroll") for (int jj = 0; jj < 4; ++jj) { v[jj] = v[jj] * rstd * gv[jj] + bv[jj]; *(f32x4*)(xr + 256 * jj) = v[jj]; \
                if (write_xn_) { u32x2 w; w.x = pk2(v[jj][0], v[jj][1]); w.y = pk2(v[jj][2], v[jj][3]); *(u32x2*)(XN + (size_t)r * DM + 4 * lane + 256 * jj) = w; } } } } while (0)

    PH_IF GEMM_IN(0, XN, MTOK, 4096, 0);
    PH_END;
    PH_IF { for (int u = gw; u < NBATCH * 16 * (SEQ / QW); u += NGW) { const int bh = u & 63, q64 = u >> 6; sb_unit(QKV, YG, bh >> 4, bh & 15, q64 * QW, vst, lane); } }
    PH_END;
    PH_IF GEMM_OUT(0, args.in[0], 3);
    PH_END;
    PH_IF GEMM_IN(1, XN, MTOK, 4096, 0);
    PH_END;
    PH_IF {
        for (int u = gw; u < NBATCH * 16 * 32; u += NGW) { const int j = u & 31, bh = u >> 5, b = bh >> 4, h = bh & 15;
            const bf16_t* kp = QKV + (size_t)(b * SEQ + j * 256 + (lane >> 3)) * 4096 + 1024 + h * 64 + 8 * (lane & 7);
            float a[8] = {0.f, 0.f, 0.f, 0.f, 0.f, 0.f, 0.f, 0.f};
#pragma unroll 4
            for (int i = 0; i < 32; ++i) { const u32x4 w = *(const u32x4*)(kp + (size_t)(8 * i) * 4096);
                a[0] += bflo(w.x); a[1] += bfhi(w.x); a[2] += bflo(w.y); a[3] += bfhi(w.y); a[4] += bflo(w.z); a[5] += bfhi(w.z); a[6] += bflo(w.w); a[7] += bfhi(w.w); }
#pragma unroll
            for (int e = 0; e < 8; ++e) { a[e] += __shfl_xor(a[e], 8); a[e] += __shfl_xor(a[e], 16); a[e] += __shfl_xor(a[e], 32); a[e] *= (1.f / 256.f); }
            if (lane < 8) { unsigned hh[8], ll[8];
#pragma unroll
                for (int e = 0; e < 8; ++e) { hh[e] = f2bf(a[e]); ll[e] = f2bf(a[e] - __builtin_bit_cast(float, hh[e] << 16)); }
                u32x4 wh, wl; wh.x = hh[0] | (hh[1] << 16); wh.y = hh[2] | (hh[3] << 16); wh.z = hh[4] | (hh[5] << 16); wh.w = hh[6] | (hh[7] << 16);
                wl.x = ll[0] | (ll[1] << 16); wl.y = ll[2] | (ll[3] << 16); wl.z = ll[4] | (ll[5] << 16); wl.w = ll[6] | (ll[7] << 16);
                *(u32x4*)(KMH + (size_t)u * 64 + 8 * lane) = wh; *(u32x4*)(KML + (size_t)u * 64 + 8 * lane) = wl; }
        }
    }
    PH_END;
    PH_IF {
        for (int u = gw; u < NBATCH * 16 * (SEQ / QW); u += NGW) { const int bh = u & 63; int q64 = u >> 6; if ((q64 >> 5) & 1) q64 = (q64 & ~31) + 31 - (q64 & 31);
            moba_own_unit(QKV, KMH, KML, YG, LSE0, SEL, bh >> 4, bh & 15, q64 * QW, vst, lane); }
    }
    PH_END;
    PH_IF {
        const int c = (int)blockIdx.x;
        for (int k = 0;; ++k) { const int U = k * G + ((k & 1) ? (G - 1 - c) : c); if (k * G >= 31 * 64) break; if (U >= 31 * 64) continue;
            const int j = U >> 6, bh = U & 63; moba_routed_unit(QKV, SEL, YG, LSE0, PA, LSEA, PB, LSEB, bh >> 4, bh & 15, j, ldsl, tid); }
        __syncthreads();
    }
    PH_END;
    PH_IF {
        const int gt = blockIdx.x * (NWAVES * 64) + tid, NGT = G * NWAVES * 64;
        for (int idx = gt; idx < MTOK * 128; idx += NGT) { const int row = idx >> 7, c8 = (idx & 127) * 8, h = c8 >> 6, b = row >> 13, t = row & (SEQ - 1);
            const int nsel = __builtin_popcount(SEL[(size_t)(b * 16 + h) * SEQ + t]);
            const float l0 = LSE0[(size_t)row * 16 + h], l1 = nsel >= 2 ? LSEA[(size_t)row * 16 + h] : -__builtin_inff(), l2 = nsel >= 3 ? LSEB[(size_t)row * 16 + h] : -__builtin_inff();
            const float mx = fmaxf(l0, fmaxf(l1, l2)); float w0 = fexp2((l0 - mx) * LOG2E), w1 = fexp2((l1 - mx) * LOG2E), w2 = fexp2((l2 - mx) * LOG2E);
            const float inv = 1.f / (w0 + w1 + w2); w0 *= inv; w1 *= inv; w2 *= inv;
            const size_t off = (size_t)row * DM + c8; const u32x4 zero = {0u, 0u, 0u, 0u};
            const u32x4 a = *(const u32x4*)(YG + off), bq = nsel >= 2 ? *(const u32x4*)(PA + off) : zero, cq = nsel >= 3 ? *(const u32x4*)(PB + off) : zero, z = *(const u32x4*)(QKV + (size_t)row * 4096 + 3072 + c8);
            u32x4 w;
            w.x = pk2((w0 * bflo(a.x) + w1 * bflo(bq.x) + w2 * bflo(cq.x)) * bflo(z.x), (w0 * bfhi(a.x) + w1 * bfhi(bq.x) + w2 * bfhi(cq.x)) * bfhi(z.x));
            w.y = pk2((w0 * bflo(a.y) + w1 * bflo(bq.y) + w2 * bflo(cq.y)) * bflo(z.y), (w0 * bfhi(a.y) + w1 * bfhi(bq.y) + w2 * bfhi(cq.y)) * bfhi(z.y));
            w.z = pk2((w0 * bflo(a.z) + w1 * bflo(bq.z) + w2 * bflo(cq.z)) * bflo(z.z), (w0 * bfhi(a.z) + w1 * bfhi(bq.z) + w2 * bfhi(cq.z)) * bfhi(z.z));
            w.w = pk2((w0 * bflo(a.w) + w1 * bflo(bq.w) + w2 * bflo(cq.w)) * bflo(z.w), (w0 * bfhi(a.w) + w1 * bfhi(bq.w) + w2 * bfhi(cq.w)) * bfhi(z.w));
            *(u32x4*)(YG + off) = w; }
    }
    PH_END;
    PH_IF GEMM_OUT(1, X, 3);
    PH_END;
    PH_IF GEMM_IN(2, XN, MTOK, 2560, 0);
    PH_END;
    PH_IF {
        band_lds_phase<0>(QKV, YG, nullptr, args.in[10], ldsl, G, tid);
    }
    PH_END;
    PH_IF GEMM_OUT(2, X, 7);
    PH_END;
#pragma unroll 1
    for (int half = 0; half < 2; ++half) {
        PH_IF GEMM_IN(3, XN + (size_t)half * 16384 * DM, 16384, 10240, half * 16384);
        PH_END;
        PH_IF {
            band_lds_phase<1>(QKV, YG, LSE0, nullptr, ldsl, G, tid);
        }
        PH_END;
        PH_IF {
            const int gt = blockIdx.x * (NWAVES * 64) + tid, NGT = G * NWAVES * 64;
            for (int idx = gt; idx < 16384 * 128; idx += NGT) { const int row = idx >> 7, c8 = (idx & 127) * 8, h = c8 >> 6;
                const float l0 = LSE0[(size_t)row * 16 + h], l1 = LSE0[(size_t)(16384 + row) * 16 + h], l2 = LSE0[(size_t)(32768 + row) * 16 + h];
                const float mx = fmaxf(l0, fmaxf(l1, l2)); float w0 = fexp2((l0 - mx) * LOG2E), w1 = fexp2((l1 - mx) * LOG2E), w2 = fexp2((l2 - mx) * LOG2E);
                const float inv = 1.f / (w0 + w1 + w2); w0 *= inv; w1 *= inv; w2 *= inv;
                const bf16_t* rp = QKV + (size_t)row * 10240 + c8;
                const u32x4 a = *(const u32x4*)rp, bq = *(const u32x4*)(rp + 3072), cq = *(const u32x4*)(rp + 6144), z = *(const u32x4*)(rp + 9216);
                u32x4 w;
                w.x = pk2((w0 * bflo(a.x) + w1 * bflo(bq.x) + w2 * bflo(cq.x)) * bflo(z.x), (w0 * bfhi(a.x) + w1 * bfhi(bq.x) + w2 * bfhi(cq.x)) * bfhi(z.x));
                w.y = pk2((w0 * bflo(a.y) + w1 * bflo(bq.y) + w2 * bflo(cq.y)) * bflo(z.y), (w0 * bfhi(a.y) + w1 * bfhi(bq.y) + w2 * bfhi(cq.y)) * bfhi(z.y));
                w.z = pk2((w0 * bflo(a.z) + w1 * bflo(bq.z) + w2 * bflo(cq.z)) * bflo(z.z), (w0 * bfhi(a.z) + w1 * bfhi(bq.z) + w2 * bfhi(cq.z)) * bfhi(z.z));
                w.w = pk2((w0 * bflo(a.w) + w1 * bflo(bq.w) + w2 * bflo(cq.w)) * bflo(z.w), (w0 * bfhi(a.w) + w1 * bfhi(bq.w) + w2 * bfhi(cq.w)) * bfhi(z.w));
                *(u32x4*)(YG + ((size_t)half * 16384 + row) * DM + c8) = w; }
        }
        PH_END;
    }
    PH_IF GEMM_OUT(3, X, 12);
    PH_END;
    PH_IF LN_PHASE(16, 17, false);
#undef IN
#undef PH_IF
#undef PH_END
}

#ifndef N_LAUNCH_MODE
#define N_LAUNCH_MODE 1
#endif
extern "C" void kernel_launch(void* const* d_in, const int* in_sizes, int n_in, void* d_out, int out_size, void* d_ws, size_t ws_size, hipStream_t stream) {
    static int grid = 0;
    if (grid == 0) {
        if (n_in != 18 || in_sizes[0] != MTOK * DM || out_size != MTOK * DM || ws_size < WS_END) { fprintf(stderr, "kernel_launch: unexpected shapes / workspace (n_in %d, ws %zu)\n", n_in, ws_size); grid = -1; return; }
        int dev = 0, cus = 0, per_cu = 0;
        hipGetDevice(&dev); hipDeviceGetAttribute(&cus, hipDeviceAttributeMultiprocessorCount, dev);
        hipFuncSetAttribute((const void*)hybrid_fwd, hipFuncAttributeMaxDynamicSharedMemorySize, LDS_BYTES);
        hipOccupancyMaxActiveBlocksPerMultiprocessor(&per_cu, (const void*)hybrid_fwd, NWAVES * 64, LDS_BYTES);
        (void)hipGetLastError();
        if (per_cu < 1) per_cu = 1;
        grid = cus;
    }
    if (grid < 0) return;
    Args a{};
    for (int i = 0; i < 18; ++i) a.in[i] = (const float*)d_in[i];
    a.out = (float*)d_out; a.ws = (unsigned char*)d_ws;
    if (hipMemsetAsync((char*)d_ws + WS_BAR, 0, BAR_BYTES, stream) != hipSuccess) { fprintf(stderr, "kernel_launch: memset of the barrier words failed\n"); return; }
#if N_LAUNCH_MODE == 1
    a.ph_lo = 0; a.ph_hi = N_PHASES;
    void* params[] = {&a};
    hipError_t e = hipLaunchCooperativeKernel((const void*)hybrid_fwd, dim3(grid), dim3(NWAVES * 64), params, LDS_BYTES, stream);
    if (e != hipSuccess) fprintf(stderr, "cooperative launch failed: %s (grid %d)\n", hipGetErrorString(e), grid);
#else
    for (int p = 0; p < N_PHASES; ++p) { a.ph_lo = p; a.ph_hi = p + 1; hipLaunchKernelGGL(hybrid_fwd, dim3(grid), dim3(NWAVES * 64), LDS_BYTES, stream, a); }
#endif
}
```

```cpp
#include <hip/hip_runtime.h>
#include <hip/hip_cooperative_groups.h>
#include <cstdio>
#include <cstdint>
#include <cmath>
namespace cg = cooperative_groups;
namespace pg8 {
#define PG8_LAS __attribute__((address_space(3)))
typedef unsigned short bf16_t;
typedef short bf16x8 __attribute__((ext_vector_type(8)));
typedef float f32x4 __attribute__((ext_vector_type(4)));
typedef unsigned u32x4 __attribute__((ext_vector_type(4)));
constexpr int BM = 256, BK = 64, HALF = 128, HTB = HALF * BK * 2  , STAGE_BYTES = 8 * HTB, NXCD = 8, WGM = 8;

__host__ __device__ __forceinline__ int lds_byte(int r, int c) { const int st = (r >> 4) * 2 + (c >> 5), rr = r & 15, cc = c & 31, ob = rr * 64 + cc * 2; return st * 1024 + (ob ^ (((ob >> 9) & 1) << 5)); }
__host__ __device__ __forceinline__ void stage_rc(int b, int& R, int& C) { const int st = b / 1024, sb = b % 1024, swz = sb ^ (((sb >> 9) & 1) << 5); R = (st >> 1) * 16 + swz / 64; C = (st & 1) * 32 + (swz % 64) / 2; }
__host__ __device__ __forceinline__ int perm32(int rho) { const int n = rho >> 4, i = rho & 15; return 8 * (i >> 2) + 4 * n + (i & 3); }

struct Unit { int pm, pn; };
struct Gemm { const bf16_t* A; const bf16_t* Bt; int M, N, K; };

struct StaticOrder {
    int nM, nN, nwg, G, c;
    __host__ __device__ void init(int M, int N, int G_, int c_) { nM = M / BM; nN = N / BM; nwg = nM * nN; G = G_; c = c_; }
    __host__ __device__ bool next(int i, Unit& u) const {
        const long L = (long)i * G + c; if (L >= nwg) return false;
        int wgid = (int)L; { const int q = nwg / NXCD, r = nwg % NXCD, xcd = wgid % NXCD, off = wgid / NXCD; wgid = (xcd < r ? xcd * (q + 1) : r * (q + 1) + (xcd - r) * q) + off; }
        const int nig = WGM * nN, gid = wgid / nig, fm = gid * WGM, gsz = (nM - fm) < WGM ? (nM - fm) : WGM;
        u.pm = fm + ((wgid % nig) % gsz); u.pn = (wgid % nig) / gsz; return true;
    }
    __device__ __forceinline__ void a_ready(const Unit&) const {}
    __device__ __forceinline__ void done(const Unit&) const {}
};

__device__ __forceinline__ unsigned cvt_pk_bf16(float lo, float hi) { unsigned r; asm volatile("v_cvt_pk_bf16_f32 %0, %1, %2" : "=v"(r) : "v"(lo), "v"(hi)); return r; }
struct EpiIn {
    static constexpr bool PERM = true, AFTER_DRAIN = false;
    bf16_t* O; int ldc; int layer; const float* rope;
    __device__ __forceinline__ void operator()(const f32x4 (&acc)[2][2][4][2], const Unit& u, int wr, int wc, int fr, int fq) const {
        const int colt = u.pn * BM;
        int kind;
        if (layer == 0) { const int part = colt >> 10; kind = part == 0 ? 3 : (part == 3 ? 4 : 0); }
        else if (layer == 1) { const int part = colt >> 10; kind = part == 0 ? 2 : (part == 1 ? 1 : (part == 3 ? 4 : 0)); }
        else if (layer == 2) { kind = colt < 1024 ? 2 : (colt == 1024 ? 1 : (colt == 1280 ? 0 : 4)); }
        else { const int part = colt >> 10; const int t3 = part % 3; kind = part == 9 ? 4 : (t3 == 0 ? 2 : (t3 == 1 ? 1 : 0)); }
        const bool rope_on = (kind == 1 || kind == 2) && ((wc & 1) == 0);
        const float sc = kind == 2 ? 0.125f * 1.4426950408889634f : (kind == 3 ? 0.125f : 1.0f);
        const int row0 = u.pm * BM + wr * 64 + fr, col0 = colt + wc * 32 + 8 * fq;
#pragma unroll
        for (int ai = 0; ai < 2; ++ai)
#pragma unroll
            for (int m = 0; m < 4; ++m) {
                const int row = row0 + ai * HALF + m * 16;
                f32x4 c0 = {1.f, 1.f, 1.f, 1.f}, c1 = c0, s0 = {0.f, 0.f, 0.f, 0.f}, s1 = s0;
                if (rope_on) { const float* rp = rope + (size_t)(row & 8191) * 16; c0 = *(const f32x4*)rp; c1 = *(const f32x4*)(rp + 4); s0 = *(const f32x4*)(rp + 8); s1 = *(const f32x4*)(rp + 12);
                    if (fq == 0) { s0 = -s0; s1 = -s1; } if (fq >= 2) { c0 = (f32x4){1.f, 1.f, 1.f, 1.f}; c1 = c0; s0 = (f32x4){0.f, 0.f, 0.f, 0.f}; s1 = s0; } }
                bf16_t* rowp = O + (size_t)row * ldc + col0;
#pragma unroll
                for (int bj = 0; bj < 2; ++bj) {
                    f32x4 v0 = acc[ai][bj][m][0], v1 = acc[ai][bj][m][1];
                    if (rope_on) {
                        f32x4 o0, o1;
#pragma unroll
                        for (int e = 0; e < 4; ++e) { o0[e] = __shfl_xor(v0[e], 16); o1[e] = __shfl_xor(v1[e], 16); }
                        v0 = v0 * c0 + o0 * s0; v1 = v1 * c1 + o1 * s1;
                    }
                    v0 = v0 * sc; v1 = v1 * sc;
                    if (kind == 4) {
#pragma unroll
                        for (int e = 0; e < 4; ++e) { v0[e] = v0[e] * __builtin_amdgcn_rcpf(1.f + __builtin_amdgcn_exp2f(-1.4426950408889634f * v0[e])); v1[e] = v1[e] * __builtin_amdgcn_rcpf(1.f + __builtin_amdgcn_exp2f(-1.4426950408889634f * v1[e])); }
                    }
                    u32x4 w; w.x = cvt_pk_bf16(v0[0], v0[1]); w.y = cvt_pk_bf16(v0[2], v0[3]); w.z = cvt_pk_bf16(v1[0], v1[1]); w.w = cvt_pk_bf16(v1[2], v1[3]);
                    *(u32x4*)(rowp + bj * HALF) = w;
                }
            }
    }
};
struct EpiOut {
    static constexpr bool PERM = false, AFTER_DRAIN = false;
    const float* X; float* T; float alpha;
    __device__ __forceinline__ void operator()(const f32x4 (&acc)[2][2][4][2], const Unit& u, int wr, int wc, int fr, int fq) const {
        const int row0 = u.pm * BM + wr * 64 + fr, col0 = u.pn * BM + wc * 32 + 4 * fq;
#pragma unroll
        for (int ai = 0; ai < 2; ++ai)
#pragma unroll
            for (int m = 0; m < 4; ++m) {
                const size_t ro = (size_t)(row0 + ai * HALF + m * 16) * 1024 + col0;
#pragma unroll
                for (int bj = 0; bj < 2; ++bj)
#pragma unroll
                    for (int n = 0; n < 2; ++n) { const size_t o = ro + bj * HALF + 16 * n; const f32x4 x = *(const f32x4*)(X + o); *(f32x4*)(T + o) = x * alpha + acc[ai][bj][m][n]; }
            }
    }
};
template <class Epi, class Sched, bool ALIGN_EPI = false, bool SP2 = false>
__device__ __forceinline__ void gemm_phase(PG8_LAS unsigned char* lds, const Gemm g, const Sched& S, const Epi& E) {
    int tid_ = threadIdx.x; asm volatile("" : "+v"(tid_));
    const int tid = tid_, wid = __builtin_amdgcn_readfirstlane(tid >> 6), lane = tid & 63, wr = wid >> 2, wc = wid & 3, fr = lane & 15, fq = lane >> 4;
    const int K = g.K, nt = K / BK;
    unsigned voffA[2], voffB[2];
#pragma unroll
    for (int i = 0; i < 2; ++i) { int R, C; stage_rc(tid * 16 + i * 8192, R, C); const int Rb = Epi::PERM ? ((R & ~31) + perm32(R & 31)) : R;
        voffA[i] = (unsigned)(R * K + C) * 2u; voffB[i] = (unsigned)(Rb * K + C) * 2u; }
    const size_t kstep = (size_t)(BK * 2);
    const size_t hstep = (size_t)HALF * K * 2;
    const size_t tstep = 2 * hstep;
    const unsigned ldsw = (unsigned)wid * 1024u;
    const int aoff = lds_byte(wr * 64 + fr, fq * 8), boff = lds_byte(wc * 32 + fr, fq * 8);
#define PG8_SA(b, h) (((b) * 2 + (h)) * HTB)
#define PG8_SB(b, h) ((4 + (b) * 2 + (h)) * HTB)
#define PG8_STAGE(bufoff, gbase, voff) do { _Pragma("unroll") for (int _i = 0; _i < 2; ++_i) \
        __builtin_amdgcn_global_load_lds((const unsigned*)((const char*)(gbase) + (voff)[_i]), (PG8_LAS unsigned*)(lds + (bufoff) + ldsw + _i * 8192), 16, 0, 0); } while (0)
#define PG8_LDA(dst, b, h) do { _Pragma("unroll") for (int m = 0; m < 4; ++m) _Pragma("unroll") for (int k = 0; k < 2; ++k) dst[m][k] = *(const PG8_LAS bf16x8*)(lds + PG8_SA(b, h) + aoff + m * 2048 + k * 1024); } while (0)
#define PG8_LDB(dst, b, h) do { _Pragma("unroll") for (int n = 0; n < 2; ++n) _Pragma("unroll") for (int k = 0; k < 2; ++k) dst[n][k] = *(const PG8_LAS bf16x8*)(lds + PG8_SB(b, h) + boff + n * 2048 + k * 1024); } while (0)
#define PG8_MMA(ai, bj, At, Bt) do { __builtin_amdgcn_s_setprio(1); _Pragma("unroll") for (int m = 0; m < 4; ++m) _Pragma("unroll") for (int n = 0; n < 2; ++n) _Pragma("unroll") for (int k = 0; k < 2; ++k) \
        acc[ai][bj][m][n] = __builtin_amdgcn_mfma_f32_16x16x32_bf16(Bt[n][k], At[m][k], acc[ai][bj][m][n], 0, 0, 0); __builtin_amdgcn_s_setprio(0); } while (0)
#define PG8_WAIT_V(n) asm volatile("s_waitcnt vmcnt(" #n ")" ::: "memory")
#define PG8_WAIT_L(n) asm volatile("s_waitcnt lgkmcnt(" #n ")" ::: "memory")
#define PG8_BAR __builtin_amdgcn_s_barrier()
#define PG8_SCHED __builtin_amdgcn_sched_barrier(0)
    Unit cur, nxt; int ui = 0;
    if (!S.next(0, cur)) return;
    f32x4 acc[2][2][4][2];
#pragma unroll
    for (int a = 0; a < 2; ++a)
#pragma unroll
        for (int b = 0; b < 2; ++b)
#pragma unroll
            for (int m = 0; m < 4; ++m)
#pragma unroll
                for (int n = 0; n < 2; ++n) acc[a][b][m][n] = (f32x4){0.f, 0.f, 0.f, 0.f};
    bf16x8 At[4][2], B0[2][2], B1[2][2];
    const char* cA = (const char*)g.A + (size_t)cur.pm * tstep; const char* cB = (const char*)g.Bt + (size_t)cur.pn * tstep;
    S.a_ready(cur);
    if constexpr (SP2) {
        PG8_STAGE(PG8_SB(0, 0), cB, voffB); PG8_STAGE(PG8_SB(0, 1), cB + hstep, voffB); PG8_STAGE(PG8_SA(0, 0), cA, voffA); PG8_STAGE(PG8_SA(0, 1), cA + hstep, voffA);
        if (wr == 1) PG8_BAR;
        PG8_WAIT_V(2); PG8_BAR;
        PG8_STAGE(PG8_SB(1, 0), cB + kstep, voffB); PG8_STAGE(PG8_SA(1, 0), cA + kstep, voffA); PG8_STAGE(PG8_SB(1, 1), cB + hstep + kstep, voffB);
        PG8_WAIT_V(6); PG8_BAR;
    } else {
        PG8_STAGE(PG8_SB(0, 0), cB, voffB); PG8_STAGE(PG8_SA(0, 0), cA, voffA); PG8_STAGE(PG8_SB(0, 1), cB + hstep, voffB); PG8_STAGE(PG8_SA(0, 1), cA + hstep, voffA);
        if (wr == 1) PG8_BAR;
        PG8_WAIT_V(4); PG8_BAR;
        PG8_STAGE(PG8_SB(1, 0), cB + kstep, voffB); PG8_STAGE(PG8_SA(1, 0), cA + kstep, voffA); PG8_STAGE(PG8_SB(1, 1), cB + hstep + kstep, voffB);
        PG8_WAIT_V(6); PG8_BAR;
    }
    for (;;) {
        const bool has_next = S.next(ui + 1, nxt);
        const char* nA = has_next ? (const char*)g.A + (size_t)nxt.pm * tstep : cA; const char* nB = has_next ? (const char*)g.Bt + (size_t)nxt.pn * tstep : cB;
        for (int t = 0; t < nt; t += 2) {
            const bool last = (t == nt - 2);
            const char* a1 = cA + (size_t)(t + 1) * kstep;
            const char* a2 = last ? nA : cA + (size_t)(t + 2) * kstep; const char* b2 = last ? nB : cB + (size_t)(t + 2) * kstep;
            const char* a3 = a2 + kstep; const char* b3 = b2 + kstep;
            if (last && has_next) S.a_ready(nxt);
            if constexpr (SP2) {
            PG8_LDB(B0, 0, 0); PG8_LDB(B1, 0, 1); PG8_SCHED; PG8_LDA(At, 0, 0); PG8_STAGE(PG8_SA(1, 1), a1 + hstep, voffA);
            PG8_WAIT_V(8); PG8_WAIT_L(0); PG8_BAR; PG8_MMA(0, 0, At, B0); PG8_MMA(0, 1, At, B1); PG8_BAR; PG8_SCHED;
            PG8_LDA(At, 0, 1); PG8_STAGE(PG8_SB(0, 0), b2, voffB); PG8_STAGE(PG8_SB(0, 1), b2 + hstep, voffB); PG8_STAGE(PG8_SA(0, 0), a2, voffA);
            PG8_WAIT_V(8); PG8_WAIT_L(0); PG8_BAR; PG8_MMA(1, 0, At, B0); PG8_MMA(1, 1, At, B1); PG8_BAR; PG8_SCHED;
            PG8_LDB(B0, 1, 0); PG8_LDB(B1, 1, 1); PG8_SCHED; PG8_LDA(At, 1, 0); PG8_STAGE(PG8_SA(0, 1), a2 + hstep, voffA);
            PG8_WAIT_V(8); PG8_WAIT_L(0); PG8_BAR; PG8_MMA(0, 0, At, B0); PG8_MMA(0, 1, At, B1); PG8_BAR; PG8_SCHED;
            PG8_LDA(At, 1, 1); PG8_STAGE(PG8_SB(1, 0), b3, voffB); PG8_STAGE(PG8_SB(1, 1), b3 + hstep, voffB); PG8_STAGE(PG8_SA(1, 0), a3, voffA);
            PG8_WAIT_V(8); PG8_WAIT_L(0); PG8_BAR; PG8_MMA(1, 0, At, B0); PG8_MMA(1, 1, At, B1); PG8_BAR; PG8_SCHED;
            } else {
            PG8_LDB(B0, 0, 0); PG8_SCHED; PG8_LDA(At, 0, 0); PG8_STAGE(PG8_SA(1, 1), a1 + hstep, voffA);
            PG8_WAIT_L(8); PG8_BAR; PG8_WAIT_L(0); PG8_MMA(0, 0, At, B0); PG8_BAR; PG8_SCHED;
            PG8_LDB(B1, 0, 1); PG8_STAGE(PG8_SB(0, 0), b2, voffB);
            PG8_BAR; PG8_WAIT_L(0); PG8_MMA(0, 1, At, B1); PG8_BAR;
            PG8_LDA(At, 0, 1); PG8_STAGE(PG8_SA(0, 0), a2, voffA);
            PG8_BAR; PG8_WAIT_L(0); PG8_MMA(1, 0, At, B0); PG8_BAR; PG8_SCHED;
            PG8_STAGE(PG8_SB(0, 1), b2 + hstep, voffB);
            PG8_WAIT_V(6); PG8_BAR; PG8_MMA(1, 1, At, B1); PG8_BAR;
            PG8_LDB(B0, 1, 0); PG8_SCHED; PG8_LDA(At, 1, 0); PG8_STAGE(PG8_SA(0, 1), a2 + hstep, voffA);
            PG8_WAIT_L(8); PG8_BAR; PG8_WAIT_L(0); PG8_MMA(0, 0, At, B0); PG8_BAR; PG8_SCHED;
            PG8_LDB(B1, 1, 1); PG8_STAGE(PG8_SB(1, 0), b3, voffB);
            PG8_BAR; PG8_WAIT_L(0); PG8_MMA(0, 1, At, B1); PG8_BAR;
            PG8_LDA(At, 1, 1); PG8_STAGE(PG8_SA(1, 0), a3, voffA);
            PG8_BAR; PG8_WAIT_L(0); PG8_MMA(1, 0, At, B0); PG8_BAR; PG8_SCHED;
            PG8_STAGE(PG8_SB(1, 1), b3 + hstep, voffB);
            PG8_WAIT_V(6); PG8_BAR; PG8_MMA(1, 1, At, B1); PG8_BAR;
            }
        }
        if constexpr (ALIGN_EPI) { if (wr == 0) PG8_BAR; }
        if constexpr (!Epi::AFTER_DRAIN) { E(acc, cur, wr, wc, fr, fq); S.done(cur); }
        if (!has_next) break;
#pragma unroll
        for (int a = 0; a < 2; ++a)
#pragma unroll
            for (int b = 0; b < 2; ++b)
#pragma unroll
                for (int m = 0; m < 4; ++m)
#pragma unroll
                    for (int n = 0; n < 2; ++n) acc[a][b][m][n] = (f32x4){0.f, 0.f, 0.f, 0.f};
        cur = nxt; cA = nA; cB = nB; ++ui;
        if constexpr (ALIGN_EPI) { if (wr == 1) PG8_BAR; }
    }
    PG8_WAIT_V(0);
    if constexpr (!ALIGN_EPI) { if (wr == 0) PG8_BAR; }
    PG8_BAR;
    if constexpr (Epi::AFTER_DRAIN) { E.fused(acc, cur, wr, wc, fr, fq, lds, wid, lane); S.done(cur); }
#undef PG8_SA
#undef PG8_SB
#undef PG8_STAGE
#undef PG8_LDA
#undef PG8_LDB
#undef PG8_MMA
#undef PG8_WAIT_V
#undef PG8_WAIT_L
#undef PG8_BAR
#undef PG8_SCHED
}
}
#define LAS __attribute__((address_space(3)))
typedef unsigned short bf16_t;
typedef short bf16x8 __attribute__((ext_vector_type(8)));
typedef short s16x4 __attribute__((ext_vector_type(4)));
typedef float f32x4 __attribute__((ext_vector_type(4)));
typedef unsigned u32x4 __attribute__((ext_vector_type(4)));
typedef unsigned u32x2 __attribute__((ext_vector_type(2)));

constexpr int SEQ = 8192, NBATCH = 4, MTOK = NBATCH * SEQ, DM = 1024, NWAVES = 8;
constexpr float LOG2E = 1.4426950408889634f, LN2F = 0.6931471805599453f, LN_EPS = 1e-5f, DN_ALPHA = 1.681792830507429f;
constexpr size_t MiB = 1u << 20;
constexpr size_t WS_ROPE = 0, WS_KMH = 512 * 1024, WS_KML = 768 * 1024, WS_LSE = 1 * MiB;
constexpr size_t WS_WIN0 = 10 * MiB, WS_WIN1 = 18 * MiB, WS_WIN2 = 26 * MiB, WS_WIN3 = 31 * MiB, WS_WOUT = 51 * MiB;
constexpr size_t WS_XN = 59 * MiB, WS_YG = 123 * MiB, WS_QKV = 187 * MiB, WS_END = 507 * MiB;
constexpr int LDS_BYTES = 147456, RING_BYTES = 131072, MISC_OFF = RING_BYTES + 320;
constexpr size_t WS_BAR = 9 * MiB, BAR_BYTES = 16384;

__device__ __forceinline__ unsigned f2bf(float f) { unsigned u = __builtin_bit_cast(unsigned, f); return (u + 0x7fffu + ((u >> 16) & 1u)) >> 16; }
__device__ __forceinline__ unsigned pk2(float lo, float hi) { return pg8::cvt_pk_bf16(lo, hi); }
__device__ __forceinline__ float bf2f(unsigned short b) { return __builtin_bit_cast(float, (unsigned)b << 16); }
__device__ __forceinline__ float bflo(unsigned w) { return __builtin_bit_cast(float, w << 16); }
__device__ __forceinline__ float bfhi(unsigned w) { return __builtin_bit_cast(float, w & 0xffff0000u); }
__device__ __forceinline__ float wave_sum(float v) {
#pragma unroll
    for (int o = 1; o < 64; o <<= 1) v += __shfl_xor(v, o);
    return v;
}
__device__ __forceinline__ float fexp2(float x) { return __builtin_amdgcn_exp2f(x); }
__device__ __forceinline__ float flog2(float x) { return __builtin_amdgcn_logf(x); }

__device__ __forceinline__ void transpose_item(const float* W, int K, int N, bf16_t* WT, LAS float* scr, int item, int lane) {
    const int nblk = N / 32, kb = item / nblk, nb = item % nblk, k0 = 64 * kb, n0 = 32 * nb;
    float wv[32];
#pragma unroll
    for (int i = 0; i < 32; ++i) wv[i] = W[(size_t)(k0 + 2 * i + (lane >> 5)) * N + n0 + (lane & 31)];
#pragma unroll
    for (int i = 0; i < 32; ++i) scr[(2 * i + (lane >> 5)) * 33 + (lane & 31)] = wv[i];
    asm volatile("s_waitcnt lgkmcnt(0)" ::: "memory");
    const int c = lane & 7;
#pragma unroll
    for (int j = 0; j < 4; ++j) { const int n = (lane >> 3) + 8 * j; const LAS float* s = scr + (8 * c) * 33 + n;
        u32x4 o; o.x = pk2(s[0 * 33], s[1 * 33]); o.y = pk2(s[2 * 33], s[3 * 33]); o.z = pk2(s[4 * 33], s[5 * 33]); o.w = pk2(s[6 * 33], s[7 * 33]);
        *(u32x4*)(WT + (size_t)(n0 + n) * K + k0 + 8 * c) = o; }
    asm volatile("s_waitcnt lgkmcnt(0)" ::: "memory");
}

constexpr int NQ = 2, QW = 16 * NQ, VROW = 144;
#define MFMA16(a, b, c) __builtin_amdgcn_mfma_f32_16x16x32_bf16((a), (b), (c), 0, 0, 0)
__device__ __forceinline__ bf16x8 ldg8(const bf16_t* p) { return *(const bf16x8*)p; }
__device__ __forceinline__ s16x4 vtr(const LAS char* p) { return __builtin_bit_cast(s16x4, __builtin_amdgcn_ds_read_tr16_b64_v4i16((LAS s16x4*)p)); }

__device__ __forceinline__ void load_kfrag(bf16x8 (&kf)[2][2], const bf16_t* Kh, int ld, int tok0, int tok1, int g) {
    const bf16_t* p0 = Kh + (size_t)tok0 * ld + 8 * g; const bf16_t* p1 = Kh + (size_t)tok1 * ld + 8 * g;
    kf[0][0] = ldg8(p0); kf[0][1] = ldg8(p0 + 32); kf[1][0] = ldg8(p1); kf[1][1] = ldg8(p1 + 32);
}
__device__ __forceinline__ void load_vraw(u32x4 (&vr)[4], const bf16_t* Vh, int ld, const int (&vtok)[4], int lane) {
#pragma unroll
    for (int i = 0; i < 4; ++i) vr[i] = *(const u32x4*)(Vh + (size_t)vtok[i] * ld + 8 * (lane & 7));
}
__device__ __forceinline__ void stage_v(LAS char* vst, const u32x4 (&vr)[4], int lane) {
    asm volatile("" ::: "memory");
#pragma unroll
    for (int i = 0; i < 4; ++i) *(LAS u32x4*)(vst + ((lane >> 3) + 8 * i) * VROW + (lane & 7) * 16) = vr[i];
    asm volatile("" ::: "memory");
}
__device__ __forceinline__ void read_vfrag(bf16x8 (&vf)[4], const LAS char* vst, int lane) {
    const int g = lane >> 4, i16 = lane & 15, q = i16 >> 2, p = i16 & 3;
    const LAS char* base = vst + (4 * g + q) * VROW + 8 * p;
#pragma unroll
    for (int dt = 0; dt < 4; ++dt) { const s16x4 lo = vtr(base + 32 * dt), hi = vtr(base + 16 * VROW + 32 * dt);
        vf[dt] = (bf16x8){lo[0], lo[1], lo[2], lo[3], hi[0], hi[1], hi[2], hi[3]}; }
    asm volatile("" ::: "memory");
}
__device__ __forceinline__ void qk_tiles(f32x4& s0, f32x4& s1, const bf16x8 (&kf)[2][2], const bf16x8 (&qf)[2]) {
    const f32x4 z = {0.f, 0.f, 0.f, 0.f};
    s0 = MFMA16(kf[0][0], qf[0], z); s0 = MFMA16(kf[0][1], qf[1], s0);
    s1 = MFMA16(kf[1][0], qf[0], z); s1 = MFMA16(kf[1][1], qf[1], s1);
}
__device__ __forceinline__ bf16x8 pack_p(const f32x4& p0, const f32x4& p1) {
    u32x4 w; w.x = pk2(p0[0], p0[1]); w.y = pk2(p0[2], p0[3]); w.z = pk2(p1[0], p1[1]); w.w = pk2(p1[2], p1[3]);
    return __builtin_bit_cast(bf16x8, w);
}
__device__ __forceinline__ void softmax_pv(f32x4 s0, f32x4 s1, float& m, float& l, f32x4 (&o)[4], const bf16x8 (&vf)[4]) {
    float mx = fmaxf(fmaxf(fmaxf(s0[0], s0[1]), fmaxf(s0[2], s0[3])), fmaxf(fmaxf(s1[0], s1[1]), fmaxf(s1[2], s1[3])));
    mx = fmaxf(mx, __shfl_xor(mx, 16)); mx = fmaxf(mx, __shfl_xor(mx, 32));
    const float mn = fmaxf(m, mx), al = fexp2(m - mn); m = mn;
    f32x4 p0, p1;
#pragma unroll
    for (int e = 0; e < 4; ++e) { p0[e] = fexp2(s0[e] - mn); p1[e] = fexp2(s1[e] - mn); }
    l = l * al + ((p0[0] + p0[1]) + (p0[2] + p0[3])) + ((p1[0] + p1[1]) + (p1[2] + p1[3]));
    const bf16x8 pf = pack_p(p0, p1);
#pragma unroll
    for (int dt = 0; dt < 4; ++dt) { o[dt] = o[dt] * al; o[dt] = MFMA16(vf[dt], pf, o[dt]); }
}
__device__ __forceinline__ void store_gated(const f32x4 (&o)[4], float inv, const bf16_t* zrow, bf16_t* yrow, int g) {
#pragma unroll
    for (int dt = 0; dt < 4; ++dt) { const u32x2 zz = *(const u32x2*)(zrow + 16 * dt + 4 * g);
        u32x2 w; w.x = pk2(o[dt][0] * inv * bflo(zz.x), o[dt][1] * inv * bfhi(zz.x)); w.y = pk2(o[dt][2] * inv * bflo(zz.y), o[dt][3] * inv * bfhi(zz.y));
        *(u32x2*)(yrow + 16 * dt + 4 * g) = w; }
}

__device__ __forceinline__ void sb_unit(const bf16_t* QKV, bf16_t* YG, int b, int h, int t0, LAS char* vst, int lane) {
    constexpr int ld = 4096;
    const int g = lane >> 4, ql = lane & 15;
    const bf16_t* Qh = QKV + h * 64; const bf16_t* Kh = QKV + 1024 + h * 64; const bf16_t* Vh = QKV + 2048 + h * 64; const bf16_t* Zh = QKV + 3072 + h * 64;
    const int rb = b * SEQ;
    bf16x8 qf[NQ][2]; f32x4 o[NQ][4]; float carry[NQ];
#pragma unroll
    for (int nq = 0; nq < NQ; ++nq) { const bf16_t* qp = Qh + (size_t)(rb + t0 + 16 * nq + ql) * ld + 8 * g; qf[nq][0] = ldg8(qp); qf[nq][1] = ldg8(qp + 32); carry[nq] = 0.f;
#pragma unroll
        for (int dt = 0; dt < 4; ++dt) o[nq][dt] = (f32x4){0.f, 0.f, 0.f, 0.f}; }
    bf16x8 kfn[2][2]; u32x4 vrn[4];
    { const int kb = t0 + QW - 32; int vt[4];
#pragma unroll
      for (int i = 0; i < 4; ++i) vt[i] = rb + kb + (lane >> 3) + 8 * i;
      load_kfrag(kfn, Kh, ld, rb + kb + ql, rb + kb + 16 + ql, g); load_vraw(vrn, Vh, ld, vt, lane); }
    for (int kb = t0 + QW - 32; kb >= 0; kb -= 32) {
        bf16x8 kf[2][2]; bf16x8 vf[4];
#pragma unroll
        for (int a = 0; a < 2; ++a)
#pragma unroll
            for (int c = 0; c < 2; ++c) kf[a][c] = kfn[a][c];
        stage_v(vst, vrn, lane);
        if (kb >= 32) { const int kn = kb - 32; int vt[4];
#pragma unroll
            for (int i = 0; i < 4; ++i) vt[i] = rb + kn + (lane >> 3) + 8 * i;
            load_kfrag(kfn, Kh, ld, rb + kn + ql, rb + kn + 16 + ql, g); load_vraw(vrn, Vh, ld, vt, lane); }
        read_vfrag(vf, vst, lane);
        bool alldone = true;
#pragma unroll
        for (int nq = 0; nq < NQ; ++nq) {
            const int t = t0 + 16 * nq + ql;
            if (kb >= t0 + 16 * nq + 16) continue;
            f32x4 z[2]; qk_tiles(z[0], z[1], kf, qf[nq]);
            f32x4 L[2], lb[2]; bool valid[2][4];
#pragma unroll
            for (int T = 0; T < 2; ++T)
#pragma unroll
                for (int e = 0; e < 4; ++e) { const float zz = z[T][e]; const int key = kb + 16 * T + 4 * g + e; valid[T][e] = key < t;
                    const float sp = fmaxf(zz, 0.f) + LN2F * flog2(1.f + fexp2(-LOG2E * fabsf(zz)));
                    L[T][e] = valid[T][e] ? -sp : 0.f; lb[T][e] = zz - sp; }
            float ex[2][4], G[2], TT[2];
#pragma unroll
            for (int T = 0; T < 2; ++T) { ex[T][3] = 0.f; ex[T][2] = L[T][3]; ex[T][1] = L[T][3] + L[T][2]; ex[T][0] = ex[T][1] + L[T][1]; const float tot = ex[T][0] + L[T][0];
                const float a1 = __shfl_down(tot, 16), a2 = __shfl_down(tot, 32), a3 = __shfl_down(tot, 48);
                G[T] = (g < 3 ? a1 : 0.f) + (g < 2 ? a2 : 0.f) + (g < 1 ? a3 : 0.f);
                TT[T] = __shfl(G[T] + tot, ql); }
            f32x4 p[2];
#pragma unroll
            for (int e = 0; e < 4; ++e) { const float b1 = carry[nq] + G[1] + ex[1][e], b0 = carry[nq] + TT[1] + G[0] + ex[0][e];
                p[1][e] = valid[1][e] ? fexp2(LOG2E * (lb[1][e] + b1)) : 0.f; p[0][e] = valid[0][e] ? fexp2(LOG2E * (lb[0][e] + b0)) : 0.f; }
            carry[nq] += TT[1] + TT[0];
            const bf16x8 pf = pack_p(p[0], p[1]);
#pragma unroll
            for (int dt = 0; dt < 4; ++dt) o[nq][dt] = MFMA16(vf[dt], pf, o[nq][dt]);
        }
#pragma unroll
        for (int nq = 0; nq < NQ; ++nq) alldone = alldone && (carry[nq] < -110.f);
        if (__all(alldone)) break;
    }
#pragma unroll
    for (int nq = 0; nq < NQ; ++nq) { const size_t row = (size_t)(rb + t0 + 16 * nq + ql); store_gated(o[nq], 1.f, Zh + row * ld, YG + row * DM + h * 64, g); }
}

#define LDS_BARRIER() asm volatile("s_waitcnt lgkmcnt(0)\n\ts_barrier" ::: "memory")
constexpr int BL_KIMG = 0, BL_VIMG = 384 * VROW;
template <int MODE>
__device__ __forceinline__ void band_lds_phase(bf16_t* QKV, bf16_t* YG, float* LSE, const float* sinks, LAS unsigned char* lds, int G, int tid) {
    const int lane = tid & 63, wave = __builtin_amdgcn_readfirstlane(tid >> 6), g = lane >> 4, ql = lane & 15;
    LAS char* Kimg = (LAS char*)lds + BL_KIMG; LAS char* Vimg = (LAS char*)lds + BL_VIMG;
    constexpr int NUNITS = MODE == 0 ? NBATCH * 4 * (SEQ / 64) : 3 * 1024;
    constexpr int ld = MODE == 0 ? 2560 : 10240, QSPAN = MODE == 0 ? 64 : 256, max_back = MODE == 0 ? 127 : 128;
    u32x4 pre[12]; bf16x8 qn[2][2];
#define BL_DECODE(U_) \
    int d_dil, d_i0, d_rowbase, d_h0; const bf16_t* d_K; \
    if (MODE == 0) { const int chunk = (U_) & 127, bk = (U_) >> 7; d_dil = 1; d_i0 = chunk * 64; d_rowbase = (bk >> 2) * SEQ; d_h0 = (bk & 3) * 4; d_K = QKV + 1024 + (bk & 3) * 64; } \
    else { const int grp = (U_) >> 10, v = (U_) & 1023; d_dil = grp == 0 ? 1 : (grp == 1 ? 4 : 16); const int nch = (SEQ / 256) / d_dil; const int chunk = v % nch, rest = v / nch; d_h0 = rest & 15; const int s = rest >> 4; \
        d_rowbase = (s / d_dil) * SEQ + (s % d_dil); d_i0 = chunk * 256; d_K = QKV + (size_t)(3 * grp + 1) * 1024 + d_h0 * 64; } \
    const int d_kw0 = d_i0 >= 128 ? d_i0 - 128 : 0, d_nrows = d_i0 + QSPAN - d_kw0; const bf16_t* d_V = d_K + (MODE == 0 ? 256 : 1024);
#define BL_LOAD(U_) do { BL_DECODE(U_) \
        const unsigned voff = (unsigned)(((tid >> 3) * d_dil * ld + 8 * (tid & 7)) * 2); const size_t cstride = (size_t)64 * d_dil * ld * 2; \
        const char* kbp = (const char*)(d_K + (size_t)(d_rowbase + d_kw0 * d_dil) * ld); const char* vbp = (const char*)(d_V + (size_t)(d_rowbase + d_kw0 * d_dil) * ld); \
        _Pragma("unroll") for (int c = 0; c < 6; ++c) { if (64 * c < d_nrows) { pre[c] = *(const u32x4*)(kbp + c * cstride + voff); pre[6 + c] = *(const u32x4*)(vbp + c * cstride + voff); } } \
        { const int h_ = MODE == 0 ? d_h0 + (wave & 3) : d_h0, q0_ = MODE == 0 ? d_i0 + 32 * (wave >> 2) : d_i0 + 32 * wave; const bf16_t* Qh_ = MODE == 0 ? QKV + h_ * 64 : d_K - 1024; \
          _Pragma("unroll") for (int nq = 0; nq < 2; ++nq) { const bf16_t* qp = Qh_ + (size_t)(d_rowbase + (q0_ + 16 * nq + ql) * d_dil) * ld + 8 * g; qn[nq][0] = ldg8(qp); qn[nq][1] = ldg8(qp + 32); } } } while (0)
    int U = (int)blockIdx.x;
    if (U < NUNITS) BL_LOAD(U);
    for (; U < NUNITS; U += G) {
        BL_DECODE(U)
        LDS_BARRIER();
        { LAS char* kw = Kimg + (tid >> 3) * VROW + (tid & 7) * 16; LAS char* vw = Vimg + (tid >> 3) * VROW + (tid & 7) * 16;
#pragma unroll
          for (int c = 0; c < 6; ++c) { if (64 * c < d_nrows) { *(LAS u32x4*)(kw + c * 64 * VROW) = pre[c]; *(LAS u32x4*)(vw + c * 64 * VROW) = pre[6 + c]; } } }
        LDS_BARRIER();
        bf16x8 qf[2][2];
#pragma unroll
        for (int nq = 0; nq < 2; ++nq) { qf[nq][0] = qn[nq][0]; qf[nq][1] = qn[nq][1]; }
        if (U + G < NUNITS) BL_LOAD(U + G);
        const int h = MODE == 0 ? d_h0 + (wave & 3) : d_h0, q0 = MODE == 0 ? d_i0 + 32 * (wave >> 2) : d_i0 + 32 * wave;
        const bf16_t* Qh = MODE == 0 ? QKV + h * 64 : d_K - 1024;
        f32x4 o[2][4]; float m[2], l[2];
        const float sink2 = MODE == 0 ? sinks[h] * LOG2E : 0.f;
#pragma unroll
        for (int nq = 0; nq < 2; ++nq) {
            m[nq] = MODE == 0 ? sink2 : -1e30f; l[nq] = (MODE == 0 && g == 0) ? 1.f : 0.f;
#pragma unroll
            for (int dt = 0; dt < 4; ++dt) o[nq][dt] = (f32x4){0.f, 0.f, 0.f, 0.f}; }
        const int kstart = q0 >= 128 ? q0 - 128 : 0;
        const int i16q = ql >> 2, i16p = ql & 3;
        for (int kb = kstart; kb < q0 + 32; kb += 32) {
            const int kr = kb - d_kw0;
            bf16x8 kf[2][2], vf[4];
#pragma unroll
            for (int T = 0; T < 2; ++T) { const LAS char* kp = Kimg + (kr + 16 * T + ql) * VROW + 16 * g; kf[T][0] = *(const LAS bf16x8*)kp; kf[T][1] = *(const LAS bf16x8*)(kp + 64); }
            { const LAS char* vb = Vimg + (kr + 4 * g + i16q) * VROW + 8 * i16p;
#pragma unroll
              for (int dt = 0; dt < 4; ++dt) { const s16x4 lo = vtr(vb + 32 * dt), hi = vtr(vb + 16 * VROW + 32 * dt); vf[dt] = (bf16x8){lo[0], lo[1], lo[2], lo[3], hi[0], hi[1], hi[2], hi[3]}; } }
#pragma unroll
            for (int nq = 0; nq < 2; ++nq) {
                const int qlo = q0 + 16 * nq;
                if (kb > qlo + 15 || kb + 31 < qlo - max_back) continue;
                const int qi = qlo + ql;
                f32x4 s[2]; qk_tiles(s[0], s[1], kf, qf[nq]);
                if (!(kb + 31 <= qlo && qlo + 15 - kb <= max_back)) {
#pragma unroll
                    for (int T = 0; T < 2; ++T)
#pragma unroll
                        for (int e = 0; e < 4; ++e) { const int dist = qi - (kb + 16 * T + 4 * g + e); s[T][e] = (dist >= 0 && dist <= max_back) ? s[T][e] : -__builtin_inff(); }
                }
                softmax_pv(s[0], s[1], m[nq], l[nq], o[nq], vf);
            }
        }
#pragma unroll
        for (int nq = 0; nq < 2; ++nq) {
            float lt = l[nq]; lt += __shfl_xor(lt, 16); lt += __shfl_xor(lt, 32);
            const float inv = 1.f / lt; const int tok = d_rowbase + (q0 + 16 * nq + ql) * d_dil;
            if (MODE == 0) store_gated(o[nq], inv, QKV + (size_t)tok * ld + 1536 + h * 64, YG + (size_t)tok * DM + h * 64, g);
            else {
                bf16_t* op = (bf16_t*)Qh + (size_t)tok * ld;
#pragma unroll
                for (int dt = 0; dt < 4; ++dt) { u32x2 w; w.x = pk2(o[nq][dt][0] * inv, o[nq][dt][1] * inv); w.y = pk2(o[nq][dt][2] * inv, o[nq][dt][3] * inv); *(u32x2*)(op + 16 * dt + 4 * g) = w; }
                if (g == 0) LSE[(size_t)((U >> 10) * 16384 + tok) * 16 + h] = (m[nq] + flog2(lt)) * LN2F;
            }
        }
    }
    __syncthreads();
#undef BL_DECODE
#undef BL_LOAD
}

__device__ __forceinline__ void moba_own_unit(const bf16_t* QKV, const bf16_t* KMH, const bf16_t* KML, bf16_t* YG, float* LSE0, unsigned* SEL, int b, int h, int t0, LAS char* vst, int lane) {
    constexpr int ld = 4096;
    const int g = lane >> 4, ql = lane & 15;
    const bf16_t* Qh = QKV + h * 64; const bf16_t* Kh = QKV + 1024 + h * 64; const bf16_t* Vh = QKV + 2048 + h * 64;
    const int rb = b * SEQ, QB = t0 >> 8;
    bf16x8 qf[NQ][2]; f32x4 o[NQ][4]; float m[NQ], l[NQ];
#pragma unroll
    for (int nq = 0; nq < NQ; ++nq) { const bf16_t* qp = Qh + (size_t)(rb + t0 + 16 * nq + ql) * ld + 8 * g; qf[nq][0] = ldg8(qp); qf[nq][1] = ldg8(qp + 32); m[nq] = -1e30f; l[nq] = 0.f;
#pragma unroll
        for (int dt = 0; dt < 4; ++dt) o[nq][dt] = (f32x4){0.f, 0.f, 0.f, 0.f}; }
    {
        const bf16_t* kmh = KMH + (size_t)((b * 16 + h) * 32) * 64; const bf16_t* kml = KML + (size_t)((b * 16 + h) * 32) * 64;
        bf16x8 ah[2][2], al[2][2];
#pragma unroll
        for (int T = 0; T < 2; ++T)
#pragma unroll
            for (int ks = 0; ks < 2; ++ks) { ah[T][ks] = ldg8(kmh + (16 * T + ql) * 64 + 32 * ks + 8 * g); al[T][ks] = ldg8(kml + (16 * T + ql) * 64 + 32 * ks + 8 * g); }
#pragma unroll
        for (int nq = 0; nq < NQ; ++nq) {
            f32x4 gt[2];
#pragma unroll
            for (int T = 0; T < 2; ++T) { f32x4 a = {0.f, 0.f, 0.f, 0.f}; a = MFMA16(al[T][0], qf[nq][0], a); a = MFMA16(al[T][1], qf[nq][1], a); a = MFMA16(ah[T][0], qf[nq][0], a); a = MFMA16(ah[T][1], qf[nq][1], a); gt[T] = a; }
            float gv[8];
#pragma unroll
            for (int T = 0; T < 2; ++T)
#pragma unroll
                for (int e = 0; e < 4; ++e) gv[4 * T + e] = (16 * T + 4 * g + e) < QB ? gt[T][e] : -__builtin_inff();
            unsigned s = 0u;
#pragma unroll
            for (int r = 0; r < 3; ++r) {
                float bv = -__builtin_inff(); int bi = 64;
#pragma unroll
                for (int c = 0; c < 8; ++c) { const int idx = 16 * (c >> 2) + 4 * g + (c & 3); if (gv[c] > bv) { bv = gv[c]; bi = idx; } }
#pragma unroll
                for (int off = 16; off < 64; off <<= 1) { const float ov = __shfl_xor(bv, off); const int oi = __shfl_xor(bi, off); if (ov > bv || (ov == bv && oi < bi)) { bv = ov; bi = oi; } }
                if (bi < 32) { s |= 1u << bi;
#pragma unroll
                    for (int c = 0; c < 8; ++c) { const int idx = 16 * (c >> 2) + 4 * g + (c & 3); if (idx == bi) gv[c] = -__builtin_inff(); } }
            }
            if (g == 0) SEL[(size_t)(b * 16 + h) * SEQ + t0 + 16 * nq + ql] = s;
        }
    }
    const int kend = t0 + QW;
    bf16x8 kfn[2][2]; u32x4 vrn[4];
#define MOBA_PREFETCH(kb_) do { const int kb__ = rb + (kb_); int vt[4]; \
        _Pragma("unroll") for (int i = 0; i < 4; ++i) vt[i] = kb__ + (lane >> 3) + 8 * i; \
        load_kfrag(kfn, Kh, ld, kb__ + ql, kb__ + 16 + ql, g); load_vraw(vrn, Vh, ld, vt, lane); } while (0)
    MOBA_PREFETCH(QB * 256);
    for (int kb = QB * 256; kb < kend; kb += 32) {
        bf16x8 kf[2][2]; bf16x8 vf[4];
#pragma unroll
        for (int a = 0; a < 2; ++a)
#pragma unroll
            for (int c = 0; c < 2; ++c) kf[a][c] = kfn[a][c];
        stage_v(vst, vrn, lane);
        if (kb + 32 < kend) MOBA_PREFETCH(kb + 32);
        read_vfrag(vf, vst, lane);
#pragma unroll
        for (int nq = 0; nq < NQ; ++nq) {
            if (kb > t0 + 16 * nq + 15) continue;
            const int t = t0 + 16 * nq + ql;
            f32x4 s[2]; qk_tiles(s[0], s[1], kf, qf[nq]);
            if (kb + 31 > t0 + 16 * nq) {
#pragma unroll
                for (int T = 0; T < 2; ++T)
#pragma unroll
                    for (int e = 0; e < 4; ++e) { const int key = kb + 16 * T + 4 * g + e; s[T][e] = (key <= t) ? s[T][e] : -__builtin_inff(); }
            }
            softmax_pv(s[0], s[1], m[nq], l[nq], o[nq], vf);
        }
    }
#undef MOBA_PREFETCH
#pragma unroll
    for (int nq = 0; nq < NQ; ++nq) { float lt = l[nq]; lt += __shfl_xor(lt, 16); lt += __shfl_xor(lt, 32);
        const float inv = 1.f / lt; const size_t row = (size_t)(rb + t0 + 16 * nq + ql); bf16_t* op = YG + row * DM + h * 64;
#pragma unroll
        for (int dt = 0; dt < 4; ++dt) { u32x2 w; w.x = pk2(o[nq][dt][0] * inv, o[nq][dt][1] * inv); w.y = pk2(o[nq][dt][2] * inv, o[nq][dt][3] * inv); *(u32x2*)(op + 16 * dt + 4 * g) = w; }
        if (g == 0) LSE0[row * 16 + h] = (m[nq] + flog2(lt)) * LN2F; }
}

constexpr int MR_KIMG = 0, MR_VIMG = 36864, MR_LIST = 73728, MR_CNT = 73728 + 32768;
__device__ __forceinline__ void moba_routed_unit(const bf16_t* QKV, const unsigned* SEL, bf16_t* YG, float* LSE0, bf16_t* PA, float* LSEA, bf16_t* PB, float* LSEB,
                                                 int b, int h, int j, LAS unsigned char* lds, int tid) {
    constexpr int ld = 4096;
    const int lane = tid & 63, wave = __builtin_amdgcn_readfirstlane(tid >> 6), g = lane >> 4, ql = lane & 15;
    LAS char* Kimg = (LAS char*)lds + MR_KIMG; LAS char* Vimg = (LAS char*)lds + MR_VIMG; LAS unsigned* list = (LAS unsigned*)(lds + MR_LIST); LAS unsigned* cnt = (LAS unsigned*)(lds + MR_CNT);
    LDS_BARRIER();
    if (tid == 0) *cnt = 0u;
    const int rb = b * SEQ + j * 256;
#pragma unroll
    for (int i = 0; i < 4; ++i) { const int chunk = tid + 512 * i, row = chunk >> 3, c = chunk & 7; const bf16_t* src = QKV + (size_t)(rb + row) * ld + h * 64 + 8 * c;
        *(LAS u32x4*)(Kimg + row * VROW + c * 16) = *(const u32x4*)(src + 1024); *(LAS u32x4*)(Vimg + row * VROW + c * 16) = *(const u32x4*)(src + 2048); }
    LDS_BARRIER();
    const unsigned* selp = SEL + (size_t)(b * 16 + h) * SEQ;
    {
        unsigned mks[16];
#pragma unroll
        for (int i = 0; i < 16; ++i) { const int tb = (j + 1) * 256 + wave * 64 + 512 * i; mks[i] = tb < SEQ ? selp[tb + lane] : 0u; }
#pragma unroll
        for (int i = 0; i < 16; ++i) { const int tb = (j + 1) * 256 + wave * 64 + 512 * i; if (tb >= SEQ) break;
            const unsigned mk = mks[i]; const bool hit = (mk >> j) & 1u;
            const unsigned long long bal = __ballot(hit); const unsigned nh = (unsigned)__popcll(bal);
            unsigned base = 0u; if (lane == 0 && nh) base = __hip_atomic_fetch_add(cnt, nh, __ATOMIC_RELAXED, __HIP_MEMORY_SCOPE_WORKGROUP);
            base = (unsigned)__builtin_amdgcn_readfirstlane((int)base);
            if (hit) { const unsigned rank = __builtin_popcount(mk & ((1u << j) - 1u)); const unsigned pos = base + (unsigned)__popcll(bal & ((1ull << lane) - 1ull)); list[pos] = (unsigned)(tb + lane) | (rank << 16); } }
    }
    LDS_BARRIER();
    const int n = (int)*cnt, ntiles = (n + 15) >> 4;
    unsigned e_n = 0u; bool valid_n = false; bf16x8 q0n = {0, 0, 0, 0, 0, 0, 0, 0}, q1n = q0n; u32x2 ovn[4]; float oldn = 0.f;
#pragma unroll
    for (int dt = 0; dt < 4; ++dt) ovn[dt] = (u32x2){0u, 0u};
#define MR_FETCH(tile_) do { const int idx_ = 16 * (tile_) + ql; valid_n = idx_ < n; e_n = list[valid_n ? idx_ : n - 1]; const size_t row_ = (size_t)(b * SEQ + (int)(e_n & 0xffffu)); \
        const bf16_t* qp_ = QKV + row_ * ld + h * 64 + 8 * g; q0n = ldg8(qp_); q1n = ldg8(qp_ + 32); \
        if (valid_n && (e_n >> 16) == 0u) { oldn = LSE0[row_ * 16 + h]; const bf16_t* op_ = YG + row_ * DM + h * 64 + 4 * g; \
            _Pragma("unroll") for (int dt = 0; dt < 4; ++dt) ovn[dt] = *(const u32x2*)(op_ + 16 * dt); } } while (0)
    if (wave < ntiles) MR_FETCH(wave);
    for (int tile = wave; tile < ntiles; tile += NWAVES) {
        const bool valid = valid_n; const unsigned e = e_n; const int t = (int)(e & 0xffffu), rank = (int)(e >> 16);
        const size_t row = (size_t)(b * SEQ + t);
        const bf16x8 q0 = q0n, q1 = q1n; const float old = oldn; u32x2 ov[4];
#pragma unroll
        for (int dt = 0; dt < 4; ++dt) ov[dt] = ovn[dt];
        if (tile + NWAVES < ntiles) MR_FETCH(tile + NWAVES);
        f32x4 s[16]; float mx = -1e30f;
#pragma unroll
        for (int T = 0; T < 16; ++T) { const LAS char* kp = Kimg + (16 * T + ql) * VROW + 16 * g; const bf16x8 a0 = *(const LAS bf16x8*)kp, a1 = *(const LAS bf16x8*)(kp + 64);
            f32x4 a = {0.f, 0.f, 0.f, 0.f}; a = MFMA16(a0, q0, a); a = MFMA16(a1, q1, a); s[T] = a; mx = fmaxf(mx, fmaxf(fmaxf(s[T][0], s[T][1]), fmaxf(s[T][2], s[T][3]))); }
        mx = fmaxf(mx, __shfl_xor(mx, 16)); mx = fmaxf(mx, __shfl_xor(mx, 32));
        float l = 0.f; f32x4 o[4];
#pragma unroll
        for (int dt = 0; dt < 4; ++dt) o[dt] = (f32x4){0.f, 0.f, 0.f, 0.f};
        const int i16q = ql >> 2, i16p = ql & 3;
#pragma unroll
        for (int k8 = 0; k8 < 8; ++k8) { f32x4 p0, p1;
#pragma unroll
            for (int c = 0; c < 4; ++c) { p0[c] = fexp2(s[2 * k8][c] - mx); p1[c] = fexp2(s[2 * k8 + 1][c] - mx); }
            l += ((p0[0] + p0[1]) + (p0[2] + p0[3])) + ((p1[0] + p1[1]) + (p1[2] + p1[3]));
            const bf16x8 pf = pack_p(p0, p1);
            const LAS char* vb = Vimg + (32 * k8 + 4 * g + i16q) * VROW + 8 * i16p;
#pragma unroll
            for (int dt = 0; dt < 4; ++dt) { const s16x4 lo = vtr(vb + 32 * dt), hi = vtr(vb + 16 * VROW + 32 * dt);
                const bf16x8 vf = (bf16x8){lo[0], lo[1], lo[2], lo[3], hi[0], hi[1], hi[2], hi[3]}; o[dt] = MFMA16(vf, pf, o[dt]); } }
        l += __shfl_xor(l, 16); l += __shfl_xor(l, 32);
        const float inv = 1.f / l, lse = (mx + flog2(l)) * LN2F;
        if (valid) {
            if (rank == 0) {
                const float mm = fmaxf(old, lse); const float wo = fexp2((old - mm) * LOG2E), wn = fexp2((lse - mm) * LOG2E); const float i2 = 1.f / (wo + wn);
                const float co = wo * i2, cn = wn * i2 * inv; bf16_t* op = YG + row * DM + h * 64;
#pragma unroll
                for (int dt = 0; dt < 4; ++dt) {
                    u32x2 w; w.x = pk2(co * bflo(ov[dt].x) + cn * o[dt][0], co * bfhi(ov[dt].x) + cn * o[dt][1]); w.y = pk2(co * bflo(ov[dt].y) + cn * o[dt][2], co * bfhi(ov[dt].y) + cn * o[dt][3]); *(u32x2*)(op + 16 * dt + 4 * g) = w; }
                if (g == 0) LSE0[row * 16 + h] = mm + flog2(wo + wn) * LN2F;
            } else {
                bf16_t* op = (rank == 1 ? PA : PB) + row * DM + h * 64; float* lp = (rank == 1 ? LSEA : LSEB);
#pragma unroll
                for (int dt = 0; dt < 4; ++dt) { u32x2 w; w.x = pk2(o[dt][0] * inv, o[dt][1] * inv); w.y = pk2(o[dt][2] * inv, o[dt][3] * inv); *(u32x2*)(op + 16 * dt + 4 * g) = w; }
                if (g == 0) lp[row * 16 + h] = lse;
            }
        }
    }
#undef MR_FETCH
}

#define XB_TMO      128
#define XB_XCNT(j)  (256  + 64 * (j))
#define XB_XSUB(j)  (1280 + 64 * (j))
#define XB_XGEN(j)  (2304 + 64 * (j))
#define XB_TOP      3328
#define XB_TOPGEN   3392
#define XCD_BAR_WORDS 3456
#define XB_SPIN_CAP (1u << 18)

__device__ __forceinline__ unsigned xb_ld(unsigned* p)              { return __hip_atomic_load(p, __ATOMIC_RELAXED, __HIP_MEMORY_SCOPE_AGENT); }
__device__ __forceinline__ unsigned xb_add(unsigned* p, unsigned v) { return __hip_atomic_fetch_add(p, v, __ATOMIC_RELAXED, __HIP_MEMORY_SCOPE_AGENT); }
__device__ __forceinline__ unsigned xb_xcc_id() { return (unsigned)__builtin_amdgcn_s_getreg((3 << 11) | 20) & 0xFu; }
#define XB_SPIN(cond, bar) do { unsigned _sp = 0; while (cond) { __builtin_amdgcn_s_sleep(1); \
    if ((++_sp & 255u) == 0u) { if (xb_ld(&(bar)[XB_TMO])) break; if (_sp > XB_SPIN_CAP) { atomicAdd(&(bar)[XB_TMO], 1u); break; } } } } while (0)

struct XcdBarrier {
    unsigned* bar; unsigned x;
    volatile LAS unsigned* st;
};

__device__ __forceinline__ XcdBarrier xcd_barrier_post(unsigned* bar, volatile LAS unsigned* st) {
    XcdBarrier b; b.bar = bar; b.x = xb_xcc_id(); b.st = st;
    if (threadIdx.x == 0) (void)xb_add(&bar[XB_XCNT(b.x)], 1u);
    return b;
}
__device__ __forceinline__ void xcd_barrier_complete(unsigned* bar, unsigned x, unsigned& nloc, unsigned& nx) {
    const unsigned G = gridDim.x * gridDim.y * gridDim.z;
    unsigned sum, cnt, mine, sp = 0u;
    for (;;) {
        sum = 0u; cnt = 0u; mine = 0u;
#pragma unroll
        for (unsigned j = 0; j < 16; ++j) { const unsigned c = xb_ld(&bar[XB_XCNT(j)]); sum += c; cnt += (c > 0u) ? 1u : 0u; mine = (j == x) ? c : mine; }
        if (sum == G) break;
        __builtin_amdgcn_s_sleep(1);
        if ((++sp & 255u) == 0u) { if (xb_ld(&bar[XB_TMO])) break; if (sp > XB_SPIN_CAP) { atomicAdd(&bar[XB_TMO], 1u); break; } }
    }
    nloc = mine > 0u ? mine : 1u; nx = cnt > 0u ? cnt : 1u;
}

__device__ __forceinline__ void xcd_barrier(const XcdBarrier& b) {
    asm volatile("s_waitcnt vmcnt(0)" ::: "memory");
    __syncthreads();
    if (threadIdx.x == 0) {
        unsigned* bar = b.bar;
        __builtin_amdgcn_s_waitcnt(0);
        unsigned nloc = b.st[0], nx = b.st[1];
        if (nloc == 0u) { xcd_barrier_complete(bar, b.x, nloc, nx); b.st[0] = nloc; b.st[1] = nx; }
        const unsigned old = xb_add(&bar[XB_XSUB(b.x)], 1u);
        const unsigned gen = old / nloc;
        if (old + 1u == (gen + 1u) * nloc) {
            __builtin_amdgcn_fence(__ATOMIC_RELEASE, "agent");
            asm volatile("s_waitcnt vmcnt(0)" ::: "memory");
            const unsigned og = xb_add(&bar[XB_TOP], 1u);
            const unsigned tg = og / nx;
            if (og + 1u == (tg + 1u) * nx) xb_add(&bar[XB_TOPGEN], 1u);
            else XB_SPIN(xb_ld(&bar[XB_TOPGEN]) == tg, bar);
            __builtin_amdgcn_fence(__ATOMIC_ACQUIRE, "agent");
            xb_add(&bar[XB_XGEN(b.x)], 1u);
            asm volatile("s_waitcnt vmcnt(0)" ::: "memory");
        } else {
            XB_SPIN(xb_ld(&bar[XB_XGEN(b.x)]) == gen, bar);
            __builtin_amdgcn_fence(__ATOMIC_ACQUIRE, "agent");
            asm volatile("s_waitcnt vmcnt(0)" ::: "memory");
        }
    }
    __syncthreads();
}

struct Args { const float* in[18]; float* out; unsigned char* ws; int ph_lo, ph_hi; };
constexpr int N_PHASES = 24;

__global__ void __launch_bounds__(NWAVES * 64, 2) hybrid_fwd(Args args) {
    extern __shared__ __attribute__((aligned(16))) unsigned char lds[];
    cg::grid_group grid = cg::this_grid();
    LAS unsigned char* ldsl = (LAS unsigned char*)lds;
    const int tid = threadIdx.x, lane = tid & 63, wave = __builtin_amdgcn_readfirstlane(tid >> 6);
    const int G = gridDim.x, gw = blockIdx.x * NWAVES + wave, NGW = G * NWAVES;
    unsigned char* ws = args.ws;
    float* rope = (float*)(ws + WS_ROPE);
    bf16_t* KMH = (bf16_t*)(ws + WS_KMH); bf16_t* KML = (bf16_t*)(ws + WS_KML); float* LSE0 = (float*)(ws + WS_LSE); float* LSEA = (float*)(ws + WS_LSE + 2 * MiB); float* LSEB = (float*)(ws + WS_LSE + 4 * MiB); unsigned* SEL = (unsigned*)(ws + WS_LSE + 6 * MiB);
    bf16_t* WIN[4] = {(bf16_t*)(ws + WS_WIN0), (bf16_t*)(ws + WS_WIN1), (bf16_t*)(ws + WS_WIN2), (bf16_t*)(ws + WS_WIN3)};
    bf16_t* WOUT = (bf16_t*)(ws + WS_WOUT);
    bf16_t* XN = (bf16_t*)(ws + WS_XN); bf16_t* YG = (bf16_t*)(ws + WS_YG); bf16_t* QKV = (bf16_t*)(ws + WS_QKV); bf16_t* PA = (bf16_t*)(ws + WS_QKV + 256 * MiB); bf16_t* PB = XN;
    float* X = args.out;
    LAS char* vst = (LAS char*)(ldsl + wave * 16384);
    const int lo = args.ph_lo, hi = args.ph_hi;
#define IN(k) (lo <= (k) && (k) < hi)
    if (tid < 64) ((LAS unsigned*)(ldsl + MISC_OFF))[tid] = 0u;
    __syncthreads();
    (void)xcd_barrier_post((unsigned*)(ws + WS_BAR), (volatile LAS unsigned*)(ldsl + MISC_OFF) + 8);
    int ph = 0;
#define PH_IF if (IN(ph))
#define PH_END do { if (IN(ph) && IN(ph + 1)) { if (ph == 0) grid.sync(); else { XcdBarrier bar_; { unsigned* bp_ = (unsigned*)(args.ws + WS_BAR); asm volatile("" : "+s"(bp_)); bar_.bar = bp_; } bar_.x = xb_xcc_id(); bar_.st = (volatile LAS unsigned*)(ldsl + MISC_OFF) + 8; xcd_barrier(bar_); } } ++ph; } while (0)

    PH_IF {
        LAS float* scr = (LAS float*)(ldsl + wave * 16384);
        const int n_in[4] = {4096, 4096, 2560, 10240}; const int w_in_idx[4] = {1, 5, 9, 14}; const int w_out_idx[4] = {2, 6, 11, 15};
#pragma unroll
        for (int mi = 0; mi < 8; ++mi) {
            const int N = mi < 4 ? n_in[mi] : 1024; const int items = 16 * (N / 32);
            const float* W = mi < 4 ? args.in[w_in_idx[mi]] : args.in[w_out_idx[mi - 4]];
            bf16_t* WT = mi < 4 ? WIN[mi] : WOUT + (size_t)(mi - 4) * 1024 * 1024;
            for (int it = gw; it < items; it += NGW) transpose_item(W, 1024, N, WT, scr, it, lane);
        }
        const int gt = blockIdx.x * (NWAVES * 64) + tid, NGT = G * NWAVES * 64;
        for (int idx = gt; idx < SEQ * 8; idx += NGT) { const int pos = idx >> 3, i = idx & 7;
            const float inv = (float)pow(500000.0, -(double)i / 8.0); const float ang = (float)pos * inv;
            double sn, cs; sincos((double)ang, &sn, &cs); rope[pos * 16 + i] = (float)cs; rope[pos * 16 + 8 + i] = (float)sn; }
        const float* x = args.in[0];
        for (size_t idx = gt; idx < (size_t)MTOK * DM / 8; idx += (size_t)NGT * 4) {
            f32x4 a[4], c[4];
#pragma unroll
            for (int r = 0; r < 4; ++r) { if (idx + (size_t)r * NGT < (size_t)MTOK * DM / 8) { a[r] = *(const f32x4*)(x + (idx + (size_t)r * NGT) * 8); c[r] = *(const f32x4*)(x + (idx + (size_t)r * NGT) * 8 + 4); } }
#pragma unroll
            for (int r = 0; r < 4; ++r) if (idx + (size_t)r * NGT < (size_t)MTOK * DM / 8) { u32x4 w; w.x = pk2(a[r][0], a[r][1]); w.y = pk2(a[r][2], a[r][3]); w.z = pk2(c[r][0], c[r][1]); w.w = pk2(c[r][2], c[r][3]); *(u32x4*)(XN + (idx + (size_t)r * NGT) * 8) = w; } }
    }
    PH_END;

#define GEMM_IN(layer_, A_, Mrows_, N_) do { pg8::Gemm gg{(A_), WIN[layer_], (Mrows_), (N_), DM}; pg8::StaticOrder S; S.init((Mrows_), (N_), G, (int)blockIdx.x); \
        pg8::EpiIn E{QKV, (N_), (layer_), rope}; pg8::gemm_phase<pg8::EpiIn, pg8::StaticOrder, true, true>(ldsl, gg, S, E); } while (0)
#define GEMM_OUT(layer_, Xsrc_) do { pg8::Gemm gg{YG, WOUT + (size_t)(layer_) * 1024 * 1024, MTOK, DM, DM}; pg8::StaticOrder S; S.init(MTOK, DM, G, (int)blockIdx.x); \
        pg8::EpiOut E{(Xsrc_), X, DN_ALPHA}; pg8::gemm_phase<pg8::EpiOut, pg8::StaticOrder, true, true>(ldsl, gg, S, E); } while (0)
#define LN_PHASE(gidx_, bidx_, write_xn_) do { const float* gp = args.in[gidx_]; const float* bp = args.in[bidx_]; \
        f32x4 gv[4], bv[4]; _Pragma("unroll") for (int jj = 0; jj < 4; ++jj) { gv[jj] = *(const f32x4*)(gp + 4 * lane + 256 * jj); bv[jj] = *(const f32x4*)(bp + 4 * lane + 256 * jj); } \
        for (int r = gw; r < MTOK; r += NGW) { float* xr = X + (size_t)r * DM + 4 * lane; f32x4 v[4]; float s = 0.f; \
            _Pragma("unroll") for (int jj = 0; jj < 4; ++jj) { v[jj] = *(const f32x4*)(xr + 256 * jj); s += (v[jj][0] + v[jj][1]) + (v[jj][2] + v[jj][3]); } \
            const float mean = wave_sum(s) * (1.f / DM); float s2 = 0.f; \
            _Pragma("unroll") for (int jj = 0; jj < 4; ++jj) { v[jj] = v[jj] - mean; s2 += (v[jj][0] * v[jj][0] + v[jj][1] * v[jj][1]) + (v[jj][2] * v[jj][2] + v[jj][3] * v[jj][3]); } \
            const float rstd = 1.f / sqrtf(wave_sum(s2) * (1.f / DM) + LN_EPS); \
            _Pragma("unroll") for (int jj = 0; jj < 4; ++jj) { v[jj] = v[jj] * rstd * gv[jj] + bv[jj]; *(f32x4*)(xr + 256 * jj) = v[jj]; \
                if (write_xn_) { u32x2 w; w.x = pk2(v[jj][0], v[jj][1]); w.y = pk2(v[jj][2], v[jj][3]); *(u32x2*)(XN + (size_t)r * DM + 4 * lane + 256 * jj) = w; } } } } while (0)

    PH_IF GEMM_IN(0, XN, MTOK, 4096);
    PH_END;
    PH_IF { for (int u = gw; u < NBATCH * 16 * (SEQ / QW); u += NGW) { const int bh = u & 63, q64 = u >> 6; sb_unit(QKV, YG, bh >> 4, bh & 15, q64 * QW, vst, lane); } }
    PH_END;
    PH_IF GEMM_OUT(0, args.in[0]);
    PH_END;
    PH_IF LN_PHASE(3, 4, true);
    PH_END;
    PH_IF GEMM_IN(1, XN, MTOK, 4096);
    PH_END;
    PH_IF {
        for (int u = gw; u < NBATCH * 16 * 32; u += NGW) { const int j = u & 31, bh = u >> 5, b = bh >> 4, h = bh & 15;
            const bf16_t* kp = QKV + (size_t)(b * SEQ + j * 256 + (lane >> 3)) * 4096 + 1024 + h * 64 + 8 * (lane & 7);
            float a[8] = {0.f, 0.f, 0.f, 0.f, 0.f, 0.f, 0.f, 0.f};
#pragma unroll 4
            for (int i = 0; i < 32; ++i) { const u32x4 w = *(const u32x4*)(kp + (size_t)(8 * i) * 4096);
                a[0] += bflo(w.x); a[1] += bfhi(w.x); a[2] += bflo(w.y); a[3] += bfhi(w.y); a[4] += bflo(w.z); a[5] += bfhi(w.z); a[6] += bflo(w.w); a[7] += bfhi(w.w); }
#pragma unroll
            for (int e = 0; e < 8; ++e) { a[e] += __shfl_xor(a[e], 8); a[e] += __shfl_xor(a[e], 16); a[e] += __shfl_xor(a[e], 32); a[e] *= (1.f / 256.f); }
            if (lane < 8) { unsigned hh[8], ll[8];
#pragma unroll
                for (int e = 0; e < 8; ++e) { hh[e] = f2bf(a[e]); ll[e] = f2bf(a[e] - __builtin_bit_cast(float, hh[e] << 16)); }
                u32x4 wh, wl; wh.x = hh[0] | (hh[1] << 16); wh.y = hh[2] | (hh[3] << 16); wh.z = hh[4] | (hh[5] << 16); wh.w = hh[6] | (hh[7] << 16);
                wl.x = ll[0] | (ll[1] << 16); wl.y = ll[2] | (ll[3] << 16); wl.z = ll[4] | (ll[5] << 16); wl.w = ll[6] | (ll[7] << 16);
                *(u32x4*)(KMH + (size_t)u * 64 + 8 * lane) = wh; *(u32x4*)(KML + (size_t)u * 64 + 8 * lane) = wl; }
        }
    }
    PH_END;
    PH_IF {
        for (int u = gw; u < NBATCH * 16 * (SEQ / QW); u += NGW) { const int bh = u & 63; int q64 = u >> 6; if ((q64 >> 5) & 1) q64 = (q64 & ~31) + 31 - (q64 & 31);
            moba_own_unit(QKV, KMH, KML, YG, LSE0, SEL, bh >> 4, bh & 15, q64 * QW, vst, lane); }
    }
    PH_END;
    PH_IF {
        const int c = (int)blockIdx.x;
        for (int k = 0;; ++k) { const int U = k * G + ((k & 1) ? (G - 1 - c) : c); if (k * G >= 31 * 64) break; if (U >= 31 * 64) continue;
            const int j = U >> 6, bh = U & 63; moba_routed_unit(QKV, SEL, YG, LSE0, PA, LSEA, PB, LSEB, bh >> 4, bh & 15, j, ldsl, tid); }
        __syncthreads();
    }
    PH_END;
    PH_IF {
        const int gt = blockIdx.x * (NWAVES * 64) + tid, NGT = G * NWAVES * 64;
        for (int idx = gt; idx < MTOK * 128; idx += NGT) { const int row = idx >> 7, c8 = (idx & 127) * 8, h = c8 >> 6, b = row >> 13, t = row & (SEQ - 1);
            const int nsel = __builtin_popcount(SEL[(size_t)(b * 16 + h) * SEQ + t]);
            const float l0 = LSE0[(size_t)row * 16 + h], l1 = nsel >= 2 ? LSEA[(size_t)row * 16 + h] : -__builtin_inff(), l2 = nsel >= 3 ? LSEB[(size_t)row * 16 + h] : -__builtin_inff();
            const float mx = fmaxf(l0, fmaxf(l1, l2)); float w0 = fexp2((l0 - mx) * LOG2E), w1 = fexp2((l1 - mx) * LOG2E), w2 = fexp2((l2 - mx) * LOG2E);
            const float inv = 1.f / (w0 + w1 + w2); w0 *= inv; w1 *= inv; w2 *= inv;
            const size_t off = (size_t)row * DM + c8; const u32x4 zero = {0u, 0u, 0u, 0u};
            const u32x4 a = *(const u32x4*)(YG + off), bq = nsel >= 2 ? *(const u32x4*)(PA + off) : zero, cq = nsel >= 3 ? *(const u32x4*)(PB + off) : zero, z = *(const u32x4*)(QKV + (size_t)row * 4096 + 3072 + c8);
            u32x4 w;
            w.x = pk2((w0 * bflo(a.x) + w1 * bflo(bq.x) + w2 * bflo(cq.x)) * bflo(z.x), (w0 * bfhi(a.x) + w1 * bfhi(bq.x) + w2 * bfhi(cq.x)) * bfhi(z.x));
            w.y = pk2((w0 * bflo(a.y) + w1 * bflo(bq.y) + w2 * bflo(cq.y)) * bflo(z.y), (w0 * bfhi(a.y) + w1 * bfhi(bq.y) + w2 * bfhi(cq.y)) * bfhi(z.y));
            w.z = pk2((w0 * bflo(a.z) + w1 * bflo(bq.z) + w2 * bflo(cq.z)) * bflo(z.z), (w0 * bfhi(a.z) + w1 * bfhi(bq.z) + w2 * bfhi(cq.z)) * bfhi(z.z));
            w.w = pk2((w0 * bflo(a.w) + w1 * bflo(bq.w) + w2 * bflo(cq.w)) * bflo(z.w), (w0 * bfhi(a.w) + w1 * bfhi(bq.w) + w2 * bfhi(cq.w)) * bfhi(z.w));
            *(u32x4*)(YG + off) = w; }
    }
    PH_END;
    PH_IF GEMM_OUT(1, X);
    PH_END;
    PH_IF LN_PHASE(7, 8, true);
    PH_END;
    PH_IF GEMM_IN(2, XN, MTOK, 2560);
    PH_END;
    PH_IF {
        band_lds_phase<0>(QKV, YG, nullptr, args.in[10], ldsl, G, tid);
    }
    PH_END;
    PH_IF GEMM_OUT(2, X);
    PH_END;
    PH_IF LN_PHASE(12, 13, true);
    PH_END;
#pragma unroll 1
    for (int half = 0; half < 2; ++half) {
        PH_IF GEMM_IN(3, XN + (size_t)half * 16384 * DM, 16384, 10240);
        PH_END;
        PH_IF {
            band_lds_phase<1>(QKV, YG, LSE0, nullptr, ldsl, G, tid);
        }
        PH_END;
        PH_IF {
            const int gt = blockIdx.x * (NWAVES * 64) + tid, NGT = G * NWAVES * 64;
            for (int idx = gt; idx < 16384 * 128; idx += NGT) { const int row = idx >> 7, c8 = (idx & 127) * 8, h = c8 >> 6;
                const float l0 = LSE0[(size_t)row * 16 + h], l1 = LSE0[(size_t)(16384 + row) * 16 + h], l2 = LSE0[(size_t)(32768 + row) * 16 + h];
                const float mx = fmaxf(l0, fmaxf(l1, l2)); float w0 = fexp2((l0 - mx) * LOG2E), w1 = fexp2((l1 - mx) * LOG2E), w2 = fexp2((l2 - mx) * LOG2E);
                const float inv = 1.f / (w0 + w1 + w2); w0 *= inv; w1 *= inv; w2 *= inv;
                const bf16_t* rp = QKV + (size_t)row * 10240 + c8;
                const u32x4 a = *(const u32x4*)rp, bq = *(const u32x4*)(rp + 3072), cq = *(const u32x4*)(rp + 6144), z = *(const u32x4*)(rp + 9216);
                u32x4 w;
                w.x = pk2((w0 * bflo(a.x) + w1 * bflo(bq.x) + w2 * bflo(cq.x)) * bflo(z.x), (w0 * bfhi(a.x) + w1 * bfhi(bq.x) + w2 * bfhi(cq.x)) * bfhi(z.x));
                w.y = pk2((w0 * bflo(a.y) + w1 * bflo(bq.y) + w2 * bflo(cq.y)) * bflo(z.y), (w0 * bfhi(a.y) + w1 * bfhi(bq.y) + w2 * bfhi(cq.y)) * bfhi(z.y));
                w.z = pk2((w0 * bflo(a.z) + w1 * bflo(bq.z) + w2 * bflo(cq.z)) * bflo(z.z), (w0 * bfhi(a.z) + w1 * bfhi(bq.z) + w2 * bfhi(cq.z)) * bfhi(z.z));
                w.w = pk2((w0 * bflo(a.w) + w1 * bflo(bq.w) + w2 * bflo(cq.w)) * bflo(z.w), (w0 * bfhi(a.w) + w1 * bfhi(bq.w) + w2 * bfhi(cq.w)) * bfhi(z.w));
                *(u32x4*)(YG + ((size_t)half * 16384 + row) * DM + c8) = w; }
        }
        PH_END;
    }
    PH_IF GEMM_OUT(3, X);
    PH_END;
    PH_IF LN_PHASE(16, 17, false);
#undef IN
#undef PH_IF
#undef PH_END
}

#ifndef N_LAUNCH_MODE
#define N_LAUNCH_MODE 1
#endif
extern "C" void kernel_launch(void* const* d_in, const int* in_sizes, int n_in, void* d_out, int out_size, void* d_ws, size_t ws_size, hipStream_t stream) {
    static int grid = 0;
    if (grid == 0) {
        if (n_in != 18 || in_sizes[0] != MTOK * DM || out_size != MTOK * DM || ws_size < WS_END) { fprintf(stderr, "kernel_launch: unexpected shapes / workspace (n_in %d, ws %zu)\n", n_in, ws_size); grid = -1; return; }
        int dev = 0, cus = 0, per_cu = 0;
        hipGetDevice(&dev); hipDeviceGetAttribute(&cus, hipDeviceAttributeMultiprocessorCount, dev);
        hipFuncSetAttribute((const void*)hybrid_fwd, hipFuncAttributeMaxDynamicSharedMemorySize, LDS_BYTES);
        hipOccupancyMaxActiveBlocksPerMultiprocessor(&per_cu, (const void*)hybrid_fwd, NWAVES * 64, LDS_BYTES);
        (void)hipGetLastError();
        if (per_cu < 1) per_cu = 1;
        grid = cus;
    }
    if (grid < 0) return;
    Args a{};
    for (int i = 0; i < 18; ++i) a.in[i] = (const float*)d_in[i];
    a.out = (float*)d_out; a.ws = (unsigned char*)d_ws;
    if (hipMemsetAsync((char*)d_ws + WS_BAR, 0, BAR_BYTES, stream) != hipSuccess) { fprintf(stderr, "kernel_launch: memset of the barrier words failed\n"); return; }
#if N_LAUNCH_MODE == 1
    a.ph_lo = 0; a.ph_hi = N_PHASES;
    void* params[] = {&a};
    hipError_t e = hipLaunchCooperativeKernel((const void*)hybrid_fwd, dim3(grid), dim3(NWAVES * 64), params, LDS_BYTES, stream);
    if (e != hipSuccess) fprintf(stderr, "cooperative launch failed: %s (grid %d)\n", hipGetErrorString(e), grid);
#else
    for (int p = 0; p < N_PHASES; ++p) { a.ph_lo = p; a.ph_hi = p + 1; hipLaunchKernelGGL(hybrid_fwd, dim3(grid), dim3(NWAVES * 64), LDS_BYTES, stream, a); }
#endif
}
```

```cpp
#include <hip/hip_runtime.h>
#include <hip/hip_cooperative_groups.h>
#include <cstdio>
#include <cstdint>
#include <cmath>
namespace cg = cooperative_groups;
namespace pg8 {
#define PG8_LAS __attribute__((address_space(3)))
typedef unsigned short bf16_t;
typedef short bf16x8 __attribute__((ext_vector_type(8)));
typedef float f32x4 __attribute__((ext_vector_type(4)));
typedef unsigned u32x4 __attribute__((ext_vector_type(4)));
constexpr int BM = 256, BK = 64, HALF = 128, HTB = HALF * BK * 2  , STAGE_BYTES = 8 * HTB, NXCD = 8, WGM = 8;

__host__ __device__ __forceinline__ int lds_byte(int r, int c) { const int st = (r >> 4) * 2 + (c >> 5), rr = r & 15, cc = c & 31, ob = rr * 64 + cc * 2; return st * 1024 + (ob ^ (((ob >> 9) & 1) << 5)); }
__host__ __device__ __forceinline__ void stage_rc(int b, int& R, int& C) { const int st = b / 1024, sb = b % 1024, swz = sb ^ (((sb >> 9) & 1) << 5); R = (st >> 1) * 16 + swz / 64; C = (st & 1) * 32 + (swz % 64) / 2; }
__host__ __device__ __forceinline__ int perm32(int rho) { const int n = rho >> 4, i = rho & 15; return 8 * (i >> 2) + 4 * n + (i & 3); }

struct Unit { int pm, pn; };
struct Gemm { const bf16_t* A; const bf16_t* Bt; int M, N, K; };

struct StaticOrder {
    int nM, nN, nwg, G, c;
    __host__ __device__ void init(int M, int N, int G_, int c_) { nM = M / BM; nN = N / BM; nwg = nM * nN; G = G_; c = c_; }
    __host__ __device__ bool next(int i, Unit& u) const {
        const long L = (long)i * G + c; if (L >= nwg) return false;
        int wgid = (int)L; { const int q = nwg / NXCD, r = nwg % NXCD, xcd = wgid % NXCD, off = wgid / NXCD; wgid = (xcd < r ? xcd * (q + 1) : r * (q + 1) + (xcd - r) * q) + off; }
        const int nig = WGM * nN, gid = wgid / nig, fm = gid * WGM, gsz = (nM - fm) < WGM ? (nM - fm) : WGM;
        u.pm = fm + ((wgid % nig) % gsz); u.pn = (wgid % nig) / gsz; return true;
    }
    __device__ __forceinline__ void a_ready(const Unit&) const {}
    __device__ __forceinline__ void done(const Unit&) const {}
};

__device__ __forceinline__ unsigned cvt_pk_bf16(float lo, float hi) { unsigned r; asm volatile("v_cvt_pk_bf16_f32 %0, %1, %2" : "=v"(r) : "v"(lo), "v"(hi)); return r; }
struct EpiIn {
    static constexpr bool PERM = true, AFTER_DRAIN = false;
    bf16_t* O; int ldc; int layer; const float* rope;
    __device__ __forceinline__ void operator()(const f32x4 (&acc)[2][2][4][2], const Unit& u, int wr, int wc, int fr, int fq) const {
        const int colt = u.pn * BM;
        int kind;
        if (layer == 0) { const int part = colt >> 10; kind = part == 0 ? 3 : (part == 3 ? 4 : 0); }
        else if (layer == 1) { const int part = colt >> 10; kind = part == 0 ? 2 : (part == 1 ? 1 : (part == 3 ? 4 : 0)); }
        else if (layer == 2) { kind = colt < 1024 ? 2 : (colt == 1024 ? 1 : (colt == 1280 ? 0 : 4)); }
        else { const int part = colt >> 10; const int t3 = part % 3; kind = part == 9 ? 4 : (t3 == 0 ? 2 : (t3 == 1 ? 1 : 0)); }
        const bool rope_on = (kind == 1 || kind == 2) && ((wc & 1) == 0);
        const float sc = kind == 2 ? 0.125f * 1.4426950408889634f : (kind == 3 ? 0.125f : 1.0f);
        const int row0 = u.pm * BM + wr * 64 + fr, col0 = colt + wc * 32 + 8 * fq;
#pragma unroll
        for (int ai = 0; ai < 2; ++ai)
#pragma unroll
            for (int m = 0; m < 4; ++m) {
                const int row = row0 + ai * HALF + m * 16;
                f32x4 c0 = {1.f, 1.f, 1.f, 1.f}, c1 = c0, s0 = {0.f, 0.f, 0.f, 0.f}, s1 = s0;
                if (rope_on) { const float* rp = rope + (size_t)(row & 8191) * 16; c0 = *(const f32x4*)rp; c1 = *(const f32x4*)(rp + 4); s0 = *(const f32x4*)(rp + 8); s1 = *(const f32x4*)(rp + 12);
                    if (fq == 0) { s0 = -s0; s1 = -s1; } if (fq >= 2) { c0 = (f32x4){1.f, 1.f, 1.f, 1.f}; c1 = c0; s0 = (f32x4){0.f, 0.f, 0.f, 0.f}; s1 = s0; } }
                bf16_t* rowp = O + (size_t)row * ldc + col0;
#pragma unroll
                for (int bj = 0; bj < 2; ++bj) {
                    f32x4 v0 = acc[ai][bj][m][0], v1 = acc[ai][bj][m][1];
                    if (rope_on) {
                        f32x4 o0, o1;
#pragma unroll
                        for (int e = 0; e < 4; ++e) { o0[e] = __shfl_xor(v0[e], 16); o1[e] = __shfl_xor(v1[e], 16); }
                        v0 = v0 * c0 + o0 * s0; v1 = v1 * c1 + o1 * s1;
                    }
                    v0 = v0 * sc; v1 = v1 * sc;
                    if (kind == 4) {
#pragma unroll
                        for (int e = 0; e < 4; ++e) { v0[e] = v0[e] * __builtin_amdgcn_rcpf(1.f + __builtin_amdgcn_exp2f(-1.4426950408889634f * v0[e])); v1[e] = v1[e] * __builtin_amdgcn_rcpf(1.f + __builtin_amdgcn_exp2f(-1.4426950408889634f * v1[e])); }
                    }
                    u32x4 w; w.x = cvt_pk_bf16(v0[0], v0[1]); w.y = cvt_pk_bf16(v0[2], v0[3]); w.z = cvt_pk_bf16(v1[0], v1[1]); w.w = cvt_pk_bf16(v1[2], v1[3]);
                    *(u32x4*)(rowp + bj * HALF) = w;
                }
            }
    }
};
struct EpiOut {
    static constexpr bool PERM = false, AFTER_DRAIN = false;
    const float* X; float* T; float alpha;
    __device__ __forceinline__ void operator()(const f32x4 (&acc)[2][2][4][2], const Unit& u, int wr, int wc, int fr, int fq) const {
        const int row0 = u.pm * BM + wr * 64 + fr, col0 = u.pn * BM + wc * 32 + 4 * fq;
#pragma unroll
        for (int ai = 0; ai < 2; ++ai)
#pragma unroll
            for (int m = 0; m < 4; ++m) {
                const size_t ro = (size_t)(row0 + ai * HALF + m * 16) * 1024 + col0;
#pragma unroll
                for (int bj = 0; bj < 2; ++bj)
#pragma unroll
                    for (int n = 0; n < 2; ++n) { const size_t o = ro + bj * HALF + 16 * n; const f32x4 x = *(const f32x4*)(X + o); *(f32x4*)(T + o) = x * alpha + acc[ai][bj][m][n]; }
            }
    }
};
template <class Epi, class Sched, bool ALIGN_EPI = false, bool SP2 = false>
__device__ __forceinline__ void gemm_phase(PG8_LAS unsigned char* lds, const Gemm g, const Sched& S, const Epi& E) {
    int tid_ = threadIdx.x; asm volatile("" : "+v"(tid_));
    const int tid = tid_, wid = __builtin_amdgcn_readfirstlane(tid >> 6), lane = tid & 63, wr = wid >> 2, wc = wid & 3, fr = lane & 15, fq = lane >> 4;
    const int K = g.K, nt = K / BK;
    unsigned voffA[2], voffB[2];
#pragma unroll
    for (int i = 0; i < 2; ++i) { int R, C; stage_rc(tid * 16 + i * 8192, R, C); const int Rb = Epi::PERM ? ((R & ~31) + perm32(R & 31)) : R;
        voffA[i] = (unsigned)(R * K + C) * 2u; voffB[i] = (unsigned)(Rb * K + C) * 2u; }
    const size_t kstep = (size_t)(BK * 2);
    const size_t hstep = (size_t)HALF * K * 2;
    const size_t tstep = 2 * hstep;
    const unsigned ldsw = (unsigned)wid * 1024u;
    const int aoff = lds_byte(wr * 64 + fr, fq * 8), boff = lds_byte(wc * 32 + fr, fq * 8);
#define PG8_SA(b, h) (((b) * 2 + (h)) * HTB)
#define PG8_SB(b, h) ((4 + (b) * 2 + (h)) * HTB)
#define PG8_STAGE(bufoff, gbase, voff) do { _Pragma("unroll") for (int _i = 0; _i < 2; ++_i) \
        __builtin_amdgcn_global_load_lds((const unsigned*)((const char*)(gbase) + (voff)[_i]), (PG8_LAS unsigned*)(lds + (bufoff) + ldsw + _i * 8192), 16, 0, 0); } while (0)
#define PG8_LDA(dst, b, h) do { _Pragma("unroll") for (int m = 0; m < 4; ++m) _Pragma("unroll") for (int k = 0; k < 2; ++k) dst[m][k] = *(const PG8_LAS bf16x8*)(lds + PG8_SA(b, h) + aoff + m * 2048 + k * 1024); } while (0)
#define PG8_LDB(dst, b, h) do { _Pragma("unroll") for (int n = 0; n < 2; ++n) _Pragma("unroll") for (int k = 0; k < 2; ++k) dst[n][k] = *(const PG8_LAS bf16x8*)(lds + PG8_SB(b, h) + boff + n * 2048 + k * 1024); } while (0)
#define PG8_MMA(ai, bj, At, Bt) do { __builtin_amdgcn_s_setprio(1); _Pragma("unroll") for (int m = 0; m < 4; ++m) _Pragma("unroll") for (int n = 0; n < 2; ++n) _Pragma("unroll") for (int k = 0; k < 2; ++k) \
        acc[ai][bj][m][n] = __builtin_amdgcn_mfma_f32_16x16x32_bf16(Bt[n][k], At[m][k], acc[ai][bj][m][n], 0, 0, 0); __builtin_amdgcn_s_setprio(0); } while (0)
#define PG8_WAIT_V(n) asm volatile("s_waitcnt vmcnt(" #n ")" ::: "memory")
#define PG8_WAIT_L(n) asm volatile("s_waitcnt lgkmcnt(" #n ")" ::: "memory")
#define PG8_BAR __builtin_amdgcn_s_barrier()
#define PG8_SCHED __builtin_amdgcn_sched_barrier(0)
    Unit cur, nxt; int ui = 0;
    if (!S.next(0, cur)) return;
    f32x4 acc[2][2][4][2];
#pragma unroll
    for (int a = 0; a < 2; ++a)
#pragma unroll
        for (int b = 0; b < 2; ++b)
#pragma unroll
            for (int m = 0; m < 4; ++m)
#pragma unroll
                for (int n = 0; n < 2; ++n) acc[a][b][m][n] = (f32x4){0.f, 0.f, 0.f, 0.f};
    bf16x8 At[4][2], B0[2][2], B1[2][2];
    const char* cA = (const char*)g.A + (size_t)cur.pm * tstep; const char* cB = (const char*)g.Bt + (size_t)cur.pn * tstep;
    S.a_ready(cur);
    if constexpr (SP2) {
        PG8_STAGE(PG8_SB(0, 0), cB, voffB); PG8_STAGE(PG8_SB(0, 1), cB + hstep, voffB); PG8_STAGE(PG8_SA(0, 0), cA, voffA); PG8_STAGE(PG8_SA(0, 1), cA + hstep, voffA);
        if (wr == 1) PG8_BAR;
        PG8_WAIT_V(2); PG8_BAR;
        PG8_STAGE(PG8_SB(1, 0), cB + kstep, voffB); PG8_STAGE(PG8_SA(1, 0), cA + kstep, voffA); PG8_STAGE(PG8_SB(1, 1), cB + hstep + kstep, voffB);
        PG8_WAIT_V(6); PG8_BAR;
    } else {
        PG8_STAGE(PG8_SB(0, 0), cB, voffB); PG8_STAGE(PG8_SA(0, 0), cA, voffA); PG8_STAGE(PG8_SB(0, 1), cB + hstep, voffB); PG8_STAGE(PG8_SA(0, 1), cA + hstep, voffA);
        if (wr == 1) PG8_BAR;
        PG8_WAIT_V(4); PG8_BAR;
        PG8_STAGE(PG8_SB(1, 0), cB + kstep, voffB); PG8_STAGE(PG8_SA(1, 0), cA + kstep, voffA); PG8_STAGE(PG8_SB(1, 1), cB + hstep + kstep, voffB);
        PG8_WAIT_V(6); PG8_BAR;
    }
    for (;;) {
        const bool has_next = S.next(ui + 1, nxt);
        const char* nA = has_next ? (const char*)g.A + (size_t)nxt.pm * tstep : cA; const char* nB = has_next ? (const char*)g.Bt + (size_t)nxt.pn * tstep : cB;
        for (int t = 0; t < nt; t += 2) {
            const bool last = (t == nt - 2);
            const char* a1 = cA + (size_t)(t + 1) * kstep;
            const char* a2 = last ? nA : cA + (size_t)(t + 2) * kstep; const char* b2 = last ? nB : cB + (size_t)(t + 2) * kstep;
            const char* a3 = a2 + kstep; const char* b3 = b2 + kstep;
            if (last && has_next) S.a_ready(nxt);
            if constexpr (SP2) {
            PG8_LDB(B0, 0, 0); PG8_LDB(B1, 0, 1); PG8_SCHED; PG8_LDA(At, 0, 0); PG8_STAGE(PG8_SA(1, 1), a1 + hstep, voffA);
            PG8_WAIT_V(8); PG8_WAIT_L(0); PG8_BAR; PG8_MMA(0, 0, At, B0); PG8_MMA(0, 1, At, B1); PG8_BAR; PG8_SCHED;
            PG8_LDA(At, 0, 1); PG8_STAGE(PG8_SB(0, 0), b2, voffB); PG8_STAGE(PG8_SB(0, 1), b2 + hstep, voffB); PG8_STAGE(PG8_SA(0, 0), a2, voffA);
            PG8_WAIT_V(8); PG8_WAIT_L(0); PG8_BAR; PG8_MMA(1, 0, At, B0); PG8_MMA(1, 1, At, B1); PG8_BAR; PG8_SCHED;
            PG8_LDB(B0, 1, 0); PG8_LDB(B1, 1, 1); PG8_SCHED; PG8_LDA(At, 1, 0); PG8_STAGE(PG8_SA(0, 1), a2 + hstep, voffA);
            PG8_WAIT_V(8); PG8_WAIT_L(0); PG8_BAR; PG8_MMA(0, 0, At, B0); PG8_MMA(0, 1, At, B1); PG8_BAR; PG8_SCHED;
            PG8_LDA(At, 1, 1); PG8_STAGE(PG8_SB(1, 0), b3, voffB); PG8_STAGE(PG8_SB(1, 1), b3 + hstep, voffB); PG8_STAGE(PG8_SA(1, 0), a3, voffA);
            PG8_WAIT_V(8); PG8_WAIT_L(0); PG8_BAR; PG8_MMA(1, 0, At, B0); PG8_MMA(1, 1, At, B1); PG8_BAR; PG8_SCHED;
            } else {
            PG8_LDB(B0, 0, 0); PG8_SCHED; PG8_LDA(At, 0, 0); PG8_STAGE(PG8_SA(1, 1), a1 + hstep, voffA);
            PG8_WAIT_L(8); PG8_BAR; PG8_WAIT_L(0); PG8_MMA(0, 0, At, B0); PG8_BAR; PG8_SCHED;
            PG8_LDB(B1, 0, 1); PG8_STAGE(PG8_SB(0, 0), b2, voffB);
            PG8_BAR; PG8_WAIT_L(0); PG8_MMA(0, 1, At, B1); PG8_BAR;
            PG8_LDA(At, 0, 1); PG8_STAGE(PG8_SA(0, 0), a2, voffA);
            PG8_BAR; PG8_WAIT_L(0); PG8_MMA(1, 0, At, B0); PG8_BAR; PG8_SCHED;
            PG8_STAGE(PG8_SB(0, 1), b2 + hstep, voffB);
            PG8_WAIT_V(6); PG8_BAR; PG8_MMA(1, 1, At, B1); PG8_BAR;
            PG8_LDB(B0, 1, 0); PG8_SCHED; PG8_LDA(At, 1, 0); PG8_STAGE(PG8_SA(0, 1), a2 + hstep, voffA);
            PG8_WAIT_L(8); PG8_BAR; PG8_WAIT_L(0); PG8_MMA(0, 0, At, B0); PG8_BAR; PG8_SCHED;
            PG8_LDB(B1, 1, 1); PG8_STAGE(PG8_SB(1, 0), b3, voffB);
            PG8_BAR; PG8_WAIT_L(0); PG8_MMA(0, 1, At, B1); PG8_BAR;
            PG8_LDA(At, 1, 1); PG8_STAGE(PG8_SA(1, 0), a3, voffA);
            PG8_BAR; PG8_WAIT_L(0); PG8_MMA(1, 0, At, B0); PG8_BAR; PG8_SCHED;
            PG8_STAGE(PG8_SB(1, 1), b3 + hstep, voffB);
            PG8_WAIT_V(6); PG8_BAR; PG8_MMA(1, 1, At, B1); PG8_BAR;
            }
        }
        if constexpr (ALIGN_EPI) { if (wr == 0) PG8_BAR; }
        if constexpr (!Epi::AFTER_DRAIN) { E(acc, cur, wr, wc, fr, fq); S.done(cur); }
        if (!has_next) break;
#pragma unroll
        for (int a = 0; a < 2; ++a)
#pragma unroll
            for (int b = 0; b < 2; ++b)
#pragma unroll
                for (int m = 0; m < 4; ++m)
#pragma unroll
                    for (int n = 0; n < 2; ++n) acc[a][b][m][n] = (f32x4){0.f, 0.f, 0.f, 0.f};
        cur = nxt; cA = nA; cB = nB; ++ui;
        if constexpr (ALIGN_EPI) { if (wr == 1) PG8_BAR; }
    }
    PG8_WAIT_V(0);
    if constexpr (!ALIGN_EPI) { if (wr == 0) PG8_BAR; }
    PG8_BAR;
    if constexpr (Epi::AFTER_DRAIN) { E.fused(acc, cur, wr, wc, fr, fq, lds, wid, lane); S.done(cur); }
#undef PG8_SA
#undef PG8_SB
#undef PG8_STAGE
#undef PG8_LDA
#undef PG8_LDB
#undef PG8_MMA
#undef PG8_WAIT_V
#undef PG8_WAIT_L
#undef PG8_BAR
#undef PG8_SCHED
}
}
#define LAS __attribute__((address_space(3)))
typedef unsigned short bf16_t;
typedef short bf16x8 __attribute__((ext_vector_type(8)));
typedef short s16x4 __attribute__((ext_vector_type(4)));
typedef float f32x4 __attribute__((ext_vector_type(4)));
typedef unsigned u32x4 __attribute__((ext_vector_type(4)));
typedef unsigned u32x2 __attribute__((ext_vector_type(2)));

constexpr int SEQ = 8192, NBATCH = 4, MTOK = NBATCH * SEQ, DM = 1024, NWAVES = 8;
constexpr float LOG2E = 1.4426950408889634f, LN2F = 0.6931471805599453f, LN_EPS = 1e-5f, DN_ALPHA = 1.681792830507429f;
constexpr size_t MiB = 1u << 20;
constexpr size_t WS_ROPE = 0, WS_KMH = 512 * 1024, WS_KML = 768 * 1024, WS_LSE = 1 * MiB;
constexpr size_t WS_WIN0 = 10 * MiB, WS_WIN1 = 18 * MiB, WS_WIN2 = 26 * MiB, WS_WIN3 = 31 * MiB, WS_WOUT = 51 * MiB;
constexpr size_t WS_XN = 59 * MiB, WS_YG = 123 * MiB, WS_QKV = 187 * MiB, WS_END = 507 * MiB;
constexpr int LDS_BYTES = 147456, RING_BYTES = 131072, MISC_OFF = RING_BYTES + 320;
constexpr size_t WS_BAR = 9 * MiB, BAR_BYTES = 16384;

__device__ __forceinline__ unsigned f2bf(float f) { unsigned u = __builtin_bit_cast(unsigned, f); return (u + 0x7fffu + ((u >> 16) & 1u)) >> 16; }
__device__ __forceinline__ unsigned pk2(float lo, float hi) { return pg8::cvt_pk_bf16(lo, hi); }
__device__ __forceinline__ float bf2f(unsigned short b) { return __builtin_bit_cast(float, (unsigned)b << 16); }
__device__ __forceinline__ float bflo(unsigned w) { return __builtin_bit_cast(float, w << 16); }
__device__ __forceinline__ float bfhi(unsigned w) { return __builtin_bit_cast(float, w & 0xffff0000u); }
__device__ __forceinline__ float wave_sum(float v) {
#pragma unroll
    for (int o = 1; o < 64; o <<= 1) v += __shfl_xor(v, o);
    return v;
}
__device__ __forceinline__ float fexp2(float x) { return __builtin_amdgcn_exp2f(x); }
__device__ __forceinline__ float flog2(float x) { return __builtin_amdgcn_logf(x); }

__device__ __forceinline__ void transpose_item(const float* W, int K, int N, bf16_t* WT, LAS float* scr, int item, int lane) {
    const int nblk = N / 32, kb = item / nblk, nb = item % nblk, k0 = 64 * kb, n0 = 32 * nb;
    float wv[32];
#pragma unroll
    for (int i = 0; i < 32; ++i) wv[i] = W[(size_t)(k0 + 2 * i + (lane >> 5)) * N + n0 + (lane & 31)];
#pragma unroll
    for (int i = 0; i < 32; ++i) scr[(2 * i + (lane >> 5)) * 33 + (lane & 31)] = wv[i];
    asm volatile("s_waitcnt lgkmcnt(0)" ::: "memory");
    const int c = lane & 7;
#pragma unroll
    for (int j = 0; j < 4; ++j) { const int n = (lane >> 3) + 8 * j; const LAS float* s = scr + (8 * c) * 33 + n;
        u32x4 o; o.x = pk2(s[0 * 33], s[1 * 33]); o.y = pk2(s[2 * 33], s[3 * 33]); o.z = pk2(s[4 * 33], s[5 * 33]); o.w = pk2(s[6 * 33], s[7 * 33]);
        *(u32x4*)(WT + (size_t)(n0 + n) * K + k0 + 8 * c) = o; }
    asm volatile("s_waitcnt lgkmcnt(0)" ::: "memory");
}

constexpr int NQ = 2, QW = 16 * NQ, VROW = 144;
#define MFMA16(a, b, c) __builtin_amdgcn_mfma_f32_16x16x32_bf16((a), (b), (c), 0, 0, 0)
__device__ __forceinline__ bf16x8 ldg8(const bf16_t* p) { return *(const bf16x8*)p; }
__device__ __forceinline__ s16x4 vtr(const LAS char* p) { return __builtin_bit_cast(s16x4, __builtin_amdgcn_ds_read_tr16_b64_v4i16((LAS s16x4*)p)); }

__device__ __forceinline__ void load_kfrag(bf16x8 (&kf)[2][2], const bf16_t* Kh, int ld, int tok0, int tok1, int g) {
    const bf16_t* p0 = Kh + (size_t)tok0 * ld + 8 * g; const bf16_t* p1 = Kh + (size_t)tok1 * ld + 8 * g;
    kf[0][0] = ldg8(p0); kf[0][1] = ldg8(p0 + 32); kf[1][0] = ldg8(p1); kf[1][1] = ldg8(p1 + 32);
}
__device__ __forceinline__ void load_vraw(u32x4 (&vr)[4], const bf16_t* Vh, int ld, const int (&vtok)[4], int lane) {
#pragma unroll
    for (int i = 0; i < 4; ++i) vr[i] = *(const u32x4*)(Vh + (size_t)vtok[i] * ld + 8 * (lane & 7));
}
__device__ __forceinline__ void stage_v(LAS char* vst, const u32x4 (&vr)[4], int lane) {
    asm volatile("" ::: "memory");
#pragma unroll
    for (int i = 0; i < 4; ++i) *(LAS u32x4*)(vst + ((lane >> 3) + 8 * i) * VROW + (lane & 7) * 16) = vr[i];
    asm volatile("" ::: "memory");
}
__device__ __forceinline__ void read_vfrag(bf16x8 (&vf)[4], const LAS char* vst, int lane) {
    const int g = lane >> 4, i16 = lane & 15, q = i16 >> 2, p = i16 & 3;
    const LAS char* base = vst + (4 * g + q) * VROW + 8 * p;
#pragma unroll
    for (int dt = 0; dt < 4; ++dt) { const s16x4 lo = vtr(base + 32 * dt), hi = vtr(base + 16 * VROW + 32 * dt);
        vf[dt] = (bf16x8){lo[0], lo[1], lo[2], lo[3], hi[0], hi[1], hi[2], hi[3]}; }
    asm volatile("" ::: "memory");
}
__device__ __forceinline__ void qk_tiles(f32x4& s0, f32x4& s1, const bf16x8 (&kf)[2][2], const bf16x8 (&qf)[2]) {
    const f32x4 z = {0.f, 0.f, 0.f, 0.f};
    s0 = MFMA16(kf[0][0], qf[0], z); s0 = MFMA16(kf[0][1], qf[1], s0);
    s1 = MFMA16(kf[1][0], qf[0], z); s1 = MFMA16(kf[1][1], qf[1], s1);
}
__device__ __forceinline__ bf16x8 pack_p(const f32x4& p0, const f32x4& p1) {
    u32x4 w; w.x = pk2(p0[0], p0[1]); w.y = pk2(p0[2], p0[3]); w.z = pk2(p1[0], p1[1]); w.w = pk2(p1[2], p1[3]);
    return __builtin_bit_cast(bf16x8, w);
}
__device__ __forceinline__ void softmax_pv(f32x4 s0, f32x4 s1, float& m, float& l, f32x4 (&o)[4], const bf16x8 (&vf)[4]) {
    float mx = fmaxf(fmaxf(fmaxf(s0[0], s0[1]), fmaxf(s0[2], s0[3])), fmaxf(fmaxf(s1[0], s1[1]), fmaxf(s1[2], s1[3])));
    mx = fmaxf(mx, __shfl_xor(mx, 16)); mx = fmaxf(mx, __shfl_xor(mx, 32));
    const float mn = fmaxf(m, mx), al = fexp2(m - mn); m = mn;
    f32x4 p0, p1;
#pragma unroll
    for (int e = 0; e < 4; ++e) { p0[e] = fexp2(s0[e] - mn); p1[e] = fexp2(s1[e] - mn); }
    l = l * al + ((p0[0] + p0[1]) + (p0[2] + p0[3])) + ((p1[0] + p1[1]) + (p1[2] + p1[3]));
    const bf16x8 pf = pack_p(p0, p1);
#pragma unroll
    for (int dt = 0; dt < 4; ++dt) { o[dt] = o[dt] * al; o[dt] = MFMA16(vf[dt], pf, o[dt]); }
}
__device__ __forceinline__ void store_gated(const f32x4 (&o)[4], float inv, const bf16_t* zrow, bf16_t* yrow, int g) {
#pragma unroll
    for (int dt = 0; dt < 4; ++dt) { const u32x2 zz = *(const u32x2*)(zrow + 16 * dt + 4 * g);
        u32x2 w; w.x = pk2(o[dt][0] * inv * bflo(zz.x), o[dt][1] * inv * bfhi(zz.x)); w.y = pk2(o[dt][2] * inv * bflo(zz.y), o[dt][3] * inv * bfhi(zz.y));
        *(u32x2*)(yrow + 16 * dt + 4 * g) = w; }
}

__device__ __forceinline__ void sb_unit(const bf16_t* QKV, bf16_t* YG, int b, int h, int t0, LAS char* vst, int lane) {
    constexpr int ld = 4096;
    const int g = lane >> 4, ql = lane & 15;
    const bf16_t* Qh = QKV + h * 64; const bf16_t* Kh = QKV + 1024 + h * 64; const bf16_t* Vh = QKV + 2048 + h * 64; const bf16_t* Zh = QKV + 3072 + h * 64;
    const int rb = b * SEQ;
    bf16x8 qf[NQ][2]; f32x4 o[NQ][4]; float carry[NQ];
#pragma unroll
    for (int nq = 0; nq < NQ; ++nq) { const bf16_t* qp = Qh + (size_t)(rb + t0 + 16 * nq + ql) * ld + 8 * g; qf[nq][0] = ldg8(qp); qf[nq][1] = ldg8(qp + 32); carry[nq] = 0.f;
#pragma unroll
        for (int dt = 0; dt < 4; ++dt) o[nq][dt] = (f32x4){0.f, 0.f, 0.f, 0.f}; }
    bf16x8 kfn[2][2]; u32x4 vrn[4];
    { const int kb = t0 + QW - 32; int vt[4];
#pragma unroll
      for (int i = 0; i < 4; ++i) vt[i] = rb + kb + (lane >> 3) + 8 * i;
      load_kfrag(kfn, Kh, ld, rb + kb + ql, rb + kb + 16 + ql, g); load_vraw(vrn, Vh, ld, vt, lane); }
    for (int kb = t0 + QW - 32; kb >= 0; kb -= 32) {
        bf16x8 kf[2][2]; bf16x8 vf[4];
#pragma unroll
        for (int a = 0; a < 2; ++a)
#pragma unroll
            for (int c = 0; c < 2; ++c) kf[a][c] = kfn[a][c];
        stage_v(vst, vrn, lane);
        if (kb >= 32) { const int kn = kb - 32; int vt[4];
#pragma unroll
            for (int i = 0; i < 4; ++i) vt[i] = rb + kn + (lane >> 3) + 8 * i;
            load_kfrag(kfn, Kh, ld, rb + kn + ql, rb + kn + 16 + ql, g); load_vraw(vrn, Vh, ld, vt, lane); }
        read_vfrag(vf, vst, lane);
        bool alldone = true;
#pragma unroll
        for (int nq = 0; nq < NQ; ++nq) {
            const int t = t0 + 16 * nq + ql;
            if (kb >= t0 + 16 * nq + 16) continue;
            f32x4 z[2]; qk_tiles(z[0], z[1], kf, qf[nq]);
            f32x4 L[2], lb[2]; bool valid[2][4];
#pragma unroll
            for (int T = 0; T < 2; ++T)
#pragma unroll
                for (int e = 0; e < 4; ++e) { const float zz = z[T][e]; const int key = kb + 16 * T + 4 * g + e; valid[T][e] = key < t;
                    const float sp = fmaxf(zz, 0.f) + LN2F * flog2(1.f + fexp2(-LOG2E * fabsf(zz)));
                    L[T][e] = valid[T][e] ? -sp : 0.f; lb[T][e] = zz - sp; }
            float ex[2][4], G[2], TT[2];
#pragma unroll
            for (int T = 0; T < 2; ++T) { ex[T][3] = 0.f; ex[T][2] = L[T][3]; ex[T][1] = L[T][3] + L[T][2]; ex[T][0] = ex[T][1] + L[T][1]; const float tot = ex[T][0] + L[T][0];
                const float a1 = __shfl_down(tot, 16), a2 = __shfl_down(tot, 32), a3 = __shfl_down(tot, 48);
                G[T] = (g < 3 ? a1 : 0.f) + (g < 2 ? a2 : 0.f) + (g < 1 ? a3 : 0.f);
                TT[T] = __shfl(G[T] + tot, ql); }
            f32x4 p[2];
#pragma unroll
            for (int e = 0; e < 4; ++e) { const float b1 = carry[nq] + G[1] + ex[1][e], b0 = carry[nq] + TT[1] + G[0] + ex[0][e];
                p[1][e] = valid[1][e] ? fexp2(LOG2E * (lb[1][e] + b1)) : 0.f; p[0][e] = valid[0][e] ? fexp2(LOG2E * (lb[0][e] + b0)) : 0.f; }
            carry[nq] += TT[1] + TT[0];
            const bf16x8 pf = pack_p(p[0], p[1]);
#pragma unroll
            for (int dt = 0; dt < 4; ++dt) o[nq][dt] = MFMA16(vf[dt], pf, o[nq][dt]);
        }
#pragma unroll
        for (int nq = 0; nq < NQ; ++nq) alldone = alldone && (carry[nq] < -110.f);
        if (__all(alldone)) break;
    }
#pragma unroll
    for (int nq = 0; nq < NQ; ++nq) { const size_t row = (size_t)(rb + t0 + 16 * nq + ql); store_gated(o[nq], 1.f, Zh + row * ld, YG + row * DM + h * 64, g); }
}

#define LDS_BARRIER() asm volatile("s_waitcnt lgkmcnt(0)\n\ts_barrier" ::: "memory")
constexpr int BL_KIMG = 0, BL_VIMG = 384 * VROW;
template <int MODE>
__device__ __forceinline__ void band_lds_phase(bf16_t* QKV, bf16_t* YG, float* LSE, const float* sinks, LAS unsigned char* lds, int G, int tid) {
    const int lane = tid & 63, wave = __builtin_amdgcn_readfirstlane(tid >> 6), g = lane >> 4, ql = lane & 15;
    LAS char* Kimg = (LAS char*)lds + BL_KIMG; LAS char* Vimg = (LAS char*)lds + BL_VIMG;
    constexpr int NUNITS = MODE == 0 ? NBATCH * 4 * (SEQ / 64) : 3 * 1024;
    constexpr int ld = MODE == 0 ? 2560 : 10240, QSPAN = MODE == 0 ? 64 : 256, max_back = MODE == 0 ? 127 : 128;
    u32x4 pre[12]; bf16x8 qn[2][2];
#define BL_DECODE(U_) \
    int d_dil, d_i0, d_rowbase, d_h0; const bf16_t* d_K; \
    if (MODE == 0) { const int chunk = (U_) & 127, bk = (U_) >> 7; d_dil = 1; d_i0 = chunk * 64; d_rowbase = (bk >> 2) * SEQ; d_h0 = (bk & 3) * 4; d_K = QKV + 1024 + (bk & 3) * 64; } \
    else { const int grp = (U_) >> 10, v = (U_) & 1023; d_dil = grp == 0 ? 1 : (grp == 1 ? 4 : 16); const int nch = (SEQ / 256) / d_dil; const int chunk = v % nch, rest = v / nch; d_h0 = rest & 15; const int s = rest >> 4; \
        d_rowbase = (s / d_dil) * SEQ + (s % d_dil); d_i0 = chunk * 256; d_K = QKV + (size_t)(3 * grp + 1) * 1024 + d_h0 * 64; } \
    const int d_kw0 = d_i0 >= 128 ? d_i0 - 128 : 0, d_nrows = d_i0 + QSPAN - d_kw0; const bf16_t* d_V = d_K + (MODE == 0 ? 256 : 1024);
#define BL_LOAD(U_) do { BL_DECODE(U_) \
        const unsigned voff = (unsigned)(((tid >> 3) * d_dil * ld + 8 * (tid & 7)) * 2); const size_t cstride = (size_t)64 * d_dil * ld * 2; \
        const char* kbp = (const char*)(d_K + (size_t)(d_rowbase + d_kw0 * d_dil) * ld); const char* vbp = (const char*)(d_V + (size_t)(d_rowbase + d_kw0 * d_dil) * ld); \
        _Pragma("unroll") for (int c = 0; c < 6; ++c) { if (64 * c < d_nrows) { pre[c] = *(const u32x4*)(kbp + c * cstride + voff); pre[6 + c] = *(const u32x4*)(vbp + c * cstride + voff); } } \
        { const int h_ = MODE == 0 ? d_h0 + (wave & 3) : d_h0, q0_ = MODE == 0 ? d_i0 + 32 * (wave >> 2) : d_i0 + 32 * wave; const bf16_t* Qh_ = MODE == 0 ? QKV + h_ * 64 : d_K - 1024; \
          _Pragma("unroll") for (int nq = 0; nq < 2; ++nq) { const bf16_t* qp = Qh_ + (size_t)(d_rowbase + (q0_ + 16 * nq + ql) * d_dil) * ld + 8 * g; qn[nq][0] = ldg8(qp); qn[nq][1] = ldg8(qp + 32); } } } while (0)
    int U = (int)blockIdx.x;
    if (U < NUNITS) BL_LOAD(U);
    for (; U < NUNITS; U += G) {
        BL_DECODE(U)
        LDS_BARRIER();
        { LAS char* kw = Kimg + (tid >> 3) * VROW + (tid & 7) * 16; LAS char* vw = Vimg + (tid >> 3) * VROW + (tid & 7) * 16;
#pragma unroll
          for (int c = 0; c < 6; ++c) { if (64 * c < d_nrows) { *(LAS u32x4*)(kw + c * 64 * VROW) = pre[c]; *(LAS u32x4*)(vw + c * 64 * VROW) = pre[6 + c]; } } }
        LDS_BARRIER();
        bf16x8 qf[2][2];
#pragma unroll
        for (int nq = 0; nq < 2; ++nq) { qf[nq][0] = qn[nq][0]; qf[nq][1] = qn[nq][1]; }
        if (U + G < NUNITS) BL_LOAD(U + G);
        const int h = MODE == 0 ? d_h0 + (wave & 3) : d_h0, q0 = MODE == 0 ? d_i0 + 32 * (wave >> 2) : d_i0 + 32 * wave;
        const bf16_t* Qh = MODE == 0 ? QKV + h * 64 : d_K - 1024;
        f32x4 o[2][4]; float m[2], l[2];
        const float sink2 = MODE == 0 ? sinks[h] * LOG2E : 0.f;
#pragma unroll
        for (int nq = 0; nq < 2; ++nq) {
            m[nq] = MODE == 0 ? sink2 : -1e30f; l[nq] = (MODE == 0 && g == 0) ? 1.f : 0.f;
#pragma unroll
            for (int dt = 0; dt < 4; ++dt) o[nq][dt] = (f32x4){0.f, 0.f, 0.f, 0.f}; }
        const int kstart = q0 >= 128 ? q0 - 128 : 0;
        const int i16q = ql >> 2, i16p = ql & 3;
        for (int kb = kstart; kb < q0 + 32; kb += 32) {
            const int kr = kb - d_kw0;
            bf16x8 kf[2][2], vf[4];
#pragma unroll
            for (int T = 0; T < 2; ++T) { const LAS char* kp = Kimg + (kr + 16 * T + ql) * VROW + 16 * g; kf[T][0] = *(const LAS bf16x8*)kp; kf[T][1] = *(const LAS bf16x8*)(kp + 64); }
            { const LAS char* vb = Vimg + (kr + 4 * g + i16q) * VROW + 8 * i16p;
#pragma unroll
              for (int dt = 0; dt < 4; ++dt) { const s16x4 lo = vtr(vb + 32 * dt), hi = vtr(vb + 16 * VROW + 32 * dt); vf[dt] = (bf16x8){lo[0], lo[1], lo[2], lo[3], hi[0], hi[1], hi[2], hi[3]}; } }
#pragma unroll
            for (int nq = 0; nq < 2; ++nq) {
                const int qlo = q0 + 16 * nq;
                if (kb > qlo + 15 || kb + 31 < qlo - max_back) continue;
                const int qi = qlo + ql;
                f32x4 s[2]; qk_tiles(s[0], s[1], kf, qf[nq]);
                if (!(kb + 31 <= qlo && qlo + 15 - kb <= max_back)) {
#pragma unroll
                    for (int T = 0; T < 2; ++T)
#pragma unroll
                        for (int e = 0; e < 4; ++e) { const int dist = qi - (kb + 16 * T + 4 * g + e); s[T][e] = (dist >= 0 && dist <= max_back) ? s[T][e] : -__builtin_inff(); }
                }
                softmax_pv(s[0], s[1], m[nq], l[nq], o[nq], vf);
            }
        }
#pragma unroll
        for (int nq = 0; nq < 2; ++nq) {
            float lt = l[nq]; lt += __shfl_xor(lt, 16); lt += __shfl_xor(lt, 32);
            const float inv = 1.f / lt; const int tok = d_rowbase + (q0 + 16 * nq + ql) * d_dil;
            if (MODE == 0) store_gated(o[nq], inv, QKV + (size_t)tok * ld + 1536 + h * 64, YG + (size_t)tok * DM + h * 64, g);
            else {
                bf16_t* op = (bf16_t*)Qh + (size_t)tok * ld;
#pragma unroll
                for (int dt = 0; dt < 4; ++dt) { u32x2 w; w.x = pk2(o[nq][dt][0] * inv, o[nq][dt][1] * inv); w.y = pk2(o[nq][dt][2] * inv, o[nq][dt][3] * inv); *(u32x2*)(op + 16 * dt + 4 * g) = w; }
                if (g == 0) LSE[(size_t)((U >> 10) * 16384 + tok) * 16 + h] = (m[nq] + flog2(lt)) * LN2F;
            }
        }
    }
    __syncthreads();
#undef BL_DECODE
#undef BL_LOAD
}

__device__ __forceinline__ void moba_own_unit(const bf16_t* QKV, const bf16_t* KMH, const bf16_t* KML, bf16_t* YG, float* LSE0, unsigned* SEL, int b, int h, int t0, LAS char* vst, int lane) {
    constexpr int ld = 4096;
    const int g = lane >> 4, ql = lane & 15;
    const bf16_t* Qh = QKV + h * 64; const bf16_t* Kh = QKV + 1024 + h * 64; const bf16_t* Vh = QKV + 2048 + h * 64;
    const int rb = b * SEQ, QB = t0 >> 8;
    bf16x8 qf[NQ][2]; f32x4 o[NQ][4]; float m[NQ], l[NQ];
#pragma unroll
    for (int nq = 0; nq < NQ; ++nq) { const bf16_t* qp = Qh + (size_t)(rb + t0 + 16 * nq + ql) * ld + 8 * g; qf[nq][0] = ldg8(qp); qf[nq][1] = ldg8(qp + 32); m[nq] = -1e30f; l[nq] = 0.f;
#pragma unroll
        for (int dt = 0; dt < 4; ++dt) o[nq][dt] = (f32x4){0.f, 0.f, 0.f, 0.f}; }
    {
        const bf16_t* kmh = KMH + (size_t)((b * 16 + h) * 32) * 64; const bf16_t* kml = KML + (size_t)((b * 16 + h) * 32) * 64;
        bf16x8 ah[2][2], al[2][2];
#pragma unroll
        for (int T = 0; T < 2; ++T)
#pragma unroll
            for (int ks = 0; ks < 2; ++ks) { ah[T][ks] = ldg8(kmh + (16 * T + ql) * 64 + 32 * ks + 8 * g); al[T][ks] = ldg8(kml + (16 * T + ql) * 64 + 32 * ks + 8 * g); }
#pragma unroll
        for (int nq = 0; nq < NQ; ++nq) {
            f32x4 gt[2];
#pragma unroll
            for (int T = 0; T < 2; ++T) { f32x4 a = {0.f, 0.f, 0.f, 0.f}; a = MFMA16(al[T][0], qf[nq][0], a); a = MFMA16(al[T][1], qf[nq][1], a); a = MFMA16(ah[T][0], qf[nq][0], a); a = MFMA16(ah[T][1], qf[nq][1], a); gt[T] = a; }
            float gv[8];
#pragma unroll
            for (int T = 0; T < 2; ++T)
#pragma unroll
                for (int e = 0; e < 4; ++e) gv[4 * T + e] = (16 * T + 4 * g + e) < QB ? gt[T][e] : -__builtin_inff();
            unsigned s = 0u;
#pragma unroll
            for (int r = 0; r < 3; ++r) {
                float bv = -__builtin_inff(); int bi = 64;
#pragma unroll
                for (int c = 0; c < 8; ++c) { const int idx = 16 * (c >> 2) + 4 * g + (c & 3); if (gv[c] > bv) { bv = gv[c]; bi = idx; } }
#pragma unroll
                for (int off = 16; off < 64; off <<= 1) { const float ov = __shfl_xor(bv, off); const int oi = __shfl_xor(bi, off); if (ov > bv || (ov == bv && oi < bi)) { bv = ov; bi = oi; } }
                if (bi < 32) { s |= 1u << bi;
#pragma unroll
                    for (int c = 0; c < 8; ++c) { const int idx = 16 * (c >> 2) + 4 * g + (c & 3); if (idx == bi) gv[c] = -__builtin_inff(); } }
            }
            if (g == 0) SEL[(size_t)(b * 16 + h) * SEQ + t0 + 16 * nq + ql] = s;
        }
    }
    const int kend = t0 + QW;
    bf16x8 kfn[2][2]; u32x4 vrn[4];
#define MOBA_PREFETCH(kb_) do { const int kb__ = rb + (kb_); int vt[4]; \
        _Pragma("unroll") for (int i = 0; i < 4; ++i) vt[i] = kb__ + (lane >> 3) + 8 * i; \
        load_kfrag(kfn, Kh, ld, kb__ + ql, kb__ + 16 + ql, g); load_vraw(vrn, Vh, ld, vt, lane); } while (0)
    MOBA_PREFETCH(QB * 256);
    for (int kb = QB * 256; kb < kend; kb += 32) {
        bf16x8 kf[2][2]; bf16x8 vf[4];
#pragma unroll
        for (int a = 0; a < 2; ++a)
#pragma unroll
            for (int c = 0; c < 2; ++c) kf[a][c] = kfn[a][c];
        stage_v(vst, vrn, lane);
        if (kb + 32 < kend) MOBA_PREFETCH(kb + 32);
        read_vfrag(vf, vst, lane);
#pragma unroll
        for (int nq = 0; nq < NQ; ++nq) {
            if (kb > t0 + 16 * nq + 15) continue;
            const int t = t0 + 16 * nq + ql;
            f32x4 s[2]; qk_tiles(s[0], s[1], kf, qf[nq]);
            if (kb + 31 > t0 + 16 * nq) {
#pragma unroll
                for (int T = 0; T < 2; ++T)
#pragma unroll
                    for (int e = 0; e < 4; ++e) { const int key = kb + 16 * T + 4 * g + e; s[T][e] = (key <= t) ? s[T][e] : -__builtin_inff(); }
            }
            softmax_pv(s[0], s[1], m[nq], l[nq], o[nq], vf);
        }
    }
#undef MOBA_PREFETCH
#pragma unroll
    for (int nq = 0; nq < NQ; ++nq) { float lt = l[nq]; lt += __shfl_xor(lt, 16); lt += __shfl_xor(lt, 32);
        const float inv = 1.f / lt; const size_t row = (size_t)(rb + t0 + 16 * nq + ql); bf16_t* op = YG + row * DM + h * 64;
#pragma unroll
        for (int dt = 0; dt < 4; ++dt) { u32x2 w; w.x = pk2(o[nq][dt][0] * inv, o[nq][dt][1] * inv); w.y = pk2(o[nq][dt][2] * inv, o[nq][dt][3] * inv); *(u32x2*)(op + 16 * dt + 4 * g) = w; }
        if (g == 0) LSE0[row * 16 + h] = (m[nq] + flog2(lt)) * LN2F; }
}

constexpr int MR_KIMG = 0, MR_VIMG = 36864, MR_LIST = 73728, MR_CNT = 73728 + 32768;
__device__ __forceinline__ void moba_routed_unit(const bf16_t* QKV, const unsigned* SEL, bf16_t* YG, float* LSE0, bf16_t* PA, float* LSEA, bf16_t* PB, float* LSEB,
                                                 int b, int h, int j, LAS unsigned char* lds, int tid) {
    constexpr int ld = 4096;
    const int lane = tid & 63, wave = __builtin_amdgcn_readfirstlane(tid >> 6), g = lane >> 4, ql = lane & 15;
    LAS char* Kimg = (LAS char*)lds + MR_KIMG; LAS char* Vimg = (LAS char*)lds + MR_VIMG; LAS unsigned* list = (LAS unsigned*)(lds + MR_LIST); LAS unsigned* cnt = (LAS unsigned*)(lds + MR_CNT);
    LDS_BARRIER();
    if (tid == 0) *cnt = 0u;
    const int rb = b * SEQ + j * 256;
#pragma unroll
    for (int i = 0; i < 4; ++i) { const int chunk = tid + 512 * i, row = chunk >> 3, c = chunk & 7; const bf16_t* src = QKV + (size_t)(rb + row) * ld + h * 64 + 8 * c;
        *(LAS u32x4*)(Kimg + row * VROW + c * 16) = *(const u32x4*)(src + 1024); *(LAS u32x4*)(Vimg + row * VROW + c * 16) = *(const u32x4*)(src + 2048); }
    LDS_BARRIER();
    const unsigned* selp = SEL + (size_t)(b * 16 + h) * SEQ;
    {
        unsigned mks[16];
#pragma unroll
        for (int i = 0; i < 16; ++i) { const int tb = (j + 1) * 256 + wave * 64 + 512 * i; mks[i] = tb < SEQ ? selp[tb + lane] : 0u; }
#pragma unroll
        for (int i = 0; i < 16; ++i) { const int tb = (j + 1) * 256 + wave * 64 + 512 * i; if (tb >= SEQ) break;
            const unsigned mk = mks[i]; const bool hit = (mk >> j) & 1u;
            const unsigned long long bal = __ballot(hit); const unsigned nh = (unsigned)__popcll(bal);
            unsigned base = 0u; if (lane == 0 && nh) base = __hip_atomic_fetch_add(cnt, nh, __ATOMIC_RELAXED, __HIP_MEMORY_SCOPE_WORKGROUP);
            base = (unsigned)__builtin_amdgcn_readfirstlane((int)base);
            if (hit) { const unsigned rank = __builtin_popcount(mk & ((1u << j) - 1u)); const unsigned pos = base + (unsigned)__popcll(bal & ((1ull << lane) - 1ull)); list[pos] = (unsigned)(tb + lane) | (rank << 16); } }
    }
    LDS_BARRIER();
    const int n = (int)*cnt, ntiles = (n + 15) >> 4;
    unsigned e_n = 0u; bool valid_n = false; bf16x8 q0n = {0, 0, 0, 0, 0, 0, 0, 0}, q1n = q0n; u32x2 ovn[4]; float oldn = 0.f;
#pragma unroll
    for (int dt = 0; dt < 4; ++dt) ovn[dt] = (u32x2){0u, 0u};
#define MR_FETCH(tile_) do { const int idx_ = 16 * (tile_) + ql; valid_n = idx_ < n; e_n = list[valid_n ? idx_ : n - 1]; const size_t row_ = (size_t)(b * SEQ + (int)(e_n & 0xffffu)); \
        const bf16_t* qp_ = QKV + row_ * ld + h * 64 + 8 * g; q0n = ldg8(qp_); q1n = ldg8(qp_ + 32); \
        if (valid_n && (e_n >> 16) == 0u) { oldn = LSE0[row_ * 16 + h]; const bf16_t* op_ = YG + row_ * DM + h * 64 + 4 * g; \
            _Pragma("unroll") for (int dt = 0; dt < 4; ++dt) ovn[dt] = *(const u32x2*)(op_ + 16 * dt); } } while (0)
    if (wave < ntiles) MR_FETCH(wave);
    for (int tile = wave; tile < ntiles; tile += NWAVES) {
        const bool valid = valid_n; const unsigned e = e_n; const int t = (int)(e & 0xffffu), rank = (int)(e >> 16);
        const size_t row = (size_t)(b * SEQ + t);
        const bf16x8 q0 = q0n, q1 = q1n; const float old = oldn; u32x2 ov[4];
#pragma unroll
        for (int dt = 0; dt < 4; ++dt) ov[dt] = ovn[dt];
        if (tile + NWAVES < ntiles) MR_FETCH(tile + NWAVES);
        f32x4 s[16]; float mx = -1e30f;
#pragma unroll
        for (int T = 0; T < 16; ++T) { const LAS char* kp = Kimg + (16 * T + ql) * VROW + 16 * g; const bf16x8 a0 = *(const LAS bf16x8*)kp, a1 = *(const LAS bf16x8*)(kp + 64);
            f32x4 a = {0.f, 0.f, 0.f, 0.f}; a = MFMA16(a0, q0, a); a = MFMA16(a1, q1, a); s[T] = a; mx = fmaxf(mx, fmaxf(fmaxf(s[T][0], s[T][1]), fmaxf(s[T][2], s[T][3]))); }
        mx = fmaxf(mx, __shfl_xor(mx, 16)); mx = fmaxf(mx, __shfl_xor(mx, 32));
        float l = 0.f; f32x4 o[4];
#pragma unroll
        for (int dt = 0; dt < 4; ++dt) o[dt] = (f32x4){0.f, 0.f, 0.f, 0.f};
        const int i16q = ql >> 2, i16p = ql & 3;
#pragma unroll
        for (int k8 = 0; k8 < 8; ++k8) { f32x4 p0, p1;
#pragma unroll
            for (int c = 0; c < 4; ++c) { p0[c] = fexp2(s[2 * k8][c] - mx); p1[c] = fexp2(s[2 * k8 + 1][c] - mx); }
            l += ((p0[0] + p0[1]) + (p0[2] + p0[3])) + ((p1[0] + p1[1]) + (p1[2] + p1[3]));
            const bf16x8 pf = pack_p(p0, p1);
            const LAS char* vb = Vimg + (32 * k8 + 4 * g + i16q) * VROW + 8 * i16p;
#pragma unroll
            for (int dt = 0; dt < 4; ++dt) { const s16x4 lo = vtr(vb + 32 * dt), hi = vtr(vb + 16 * VROW + 32 * dt);
                const bf16x8 vf = (bf16x8){lo[0], lo[1], lo[2], lo[3], hi[0], hi[1], hi[2], hi[3]}; o[dt] = MFMA16(vf, pf, o[dt]); } }
        l += __shfl_xor(l, 16); l += __shfl_xor(l, 32);
        const float inv = 1.f / l, lse = (mx + flog2(l)) * LN2F;
        if (valid) {
            if (rank == 0) {
                const float mm = fmaxf(old, lse); const float wo = fexp2((old - mm) * LOG2E), wn = fexp2((lse - mm) * LOG2E); const float i2 = 1.f / (wo + wn);
                const float co = wo * i2, cn = wn * i2 * inv; bf16_t* op = YG + row * DM + h * 64;
#pragma unroll
                for (int dt = 0; dt < 4; ++dt) {
                    u32x2 w; w.x = pk2(co * bflo(ov[dt].x) + cn * o[dt][0], co * bfhi(ov[dt].x) + cn * o[dt][1]); w.y = pk2(co * bflo(ov[dt].y) + cn * o[dt][2], co * bfhi(ov[dt].y) + cn * o[dt][3]); *(u32x2*)(op + 16 * dt + 4 * g) = w; }
                if (g == 0) LSE0[row * 16 + h] = mm + flog2(wo + wn) * LN2F;
            } else {
                bf16_t* op = (rank == 1 ? PA : PB) + row * DM + h * 64; float* lp = (rank == 1 ? LSEA : LSEB);
#pragma unroll
                for (int dt = 0; dt < 4; ++dt) { u32x2 w; w.x = pk2(o[dt][0] * inv, o[dt][1] * inv); w.y = pk2(o[dt][2] * inv, o[dt][3] * inv); *(u32x2*)(op + 16 * dt + 4 * g) = w; }
                if (g == 0) lp[row * 16 + h] = lse;
            }
        }
    }
#undef MR_FETCH
}

#define XB_TMO      128
#define XB_XCNT(j)  (256  + 64 * (j))
#define XB_XSUB(j)  (1280 + 64 * (j))
#define XB_XGEN(j)  (2304 + 64 * (j))
#define XB_TOP      3328
#define XB_TOPGEN   3392
#define XCD_BAR_WORDS 3456
#define XB_SPIN_CAP (1u << 18)

__device__ __forceinline__ unsigned xb_ld(unsigned* p)              { return __hip_atomic_load(p, __ATOMIC_RELAXED, __HIP_MEMORY_SCOPE_AGENT); }
__device__ __forceinline__ unsigned xb_add(unsigned* p, unsigned v) { return __hip_atomic_fetch_add(p, v, __ATOMIC_RELAXED, __HIP_MEMORY_SCOPE_AGENT); }
__device__ __forceinline__ unsigned xb_xcc_id() { return (unsigned)__builtin_amdgcn_s_getreg((3 << 11) | 20) & 0xFu; }
#define XB_SPIN(cond, bar) do { unsigned _sp = 0; while (cond) { __builtin_amdgcn_s_sleep(1); \
    if ((++_sp & 255u) == 0u) { if (xb_ld(&(bar)[XB_TMO])) break; if (_sp > XB_SPIN_CAP) { atomicAdd(&(bar)[XB_TMO], 1u); break; } } } } while (0)

struct XcdBarrier {
    unsigned* bar; unsigned x;
    volatile LAS unsigned* st;
};

__device__ __forceinline__ XcdBarrier xcd_barrier_post(unsigned* bar, volatile LAS unsigned* st) {
    XcdBarrier b; b.bar = bar; b.x = xb_xcc_id(); b.st = st;
    if (threadIdx.x == 0) (void)xb_add(&bar[XB_XCNT(b.x)], 1u);
    return b;
}
__device__ __forceinline__ void xcd_barrier_complete(unsigned* bar, unsigned x, unsigned& nloc, unsigned& nx) {
    const unsigned G = gridDim.x * gridDim.y * gridDim.z;
    unsigned sum, cnt, mine, sp = 0u;
    for (;;) {
        sum = 0u; cnt = 0u; mine = 0u;
#pragma unroll
        for (unsigned j = 0; j < 16; ++j) { const unsigned c = xb_ld(&bar[XB_XCNT(j)]); sum += c; cnt += (c > 0u) ? 1u : 0u; mine = (j == x) ? c : mine; }
        if (sum == G) break;
        __builtin_amdgcn_s_sleep(1);
        if ((++sp & 255u) == 0u) { if (xb_ld(&bar[XB_TMO])) break; if (sp > XB_SPIN_CAP) { atomicAdd(&bar[XB_TMO], 1u); break; } }
    }
    nloc = mine > 0u ? mine : 1u; nx = cnt > 0u ? cnt : 1u;
}

__device__ __forceinline__ void xcd_barrier(const XcdBarrier& b) {
    asm volatile("s_waitcnt vmcnt(0)" ::: "memory");
    __syncthreads();
    if (threadIdx.x == 0) {
        unsigned* bar = b.bar;
        __builtin_amdgcn_s_waitcnt(0);
        unsigned nloc = b.st[0], nx = b.st[1];
        if (nloc == 0u) { xcd_barrier_complete(bar, b.x, nloc, nx); b.st[0] = nloc; b.st[1] = nx; }
        const unsigned old = xb_add(&bar[XB_XSUB(b.x)], 1u);
        const unsigned gen = old / nloc;
        if (old + 1u == (gen + 1u) * nloc) {
            __builtin_amdgcn_fence(__ATOMIC_RELEASE, "agent");
            asm volatile("s_waitcnt vmcnt(0)" ::: "memory");
            const unsigned og = xb_add(&bar[XB_TOP], 1u);
            const unsigned tg = og / nx;
            if (og + 1u == (tg + 1u) * nx) xb_add(&bar[XB_TOPGEN], 1u);
            else XB_SPIN(xb_ld(&bar[XB_TOPGEN]) == tg, bar);
            __builtin_amdgcn_fence(__ATOMIC_ACQUIRE, "agent");
            xb_add(&bar[XB_XGEN(b.x)], 1u);
            asm volatile("s_waitcnt vmcnt(0)" ::: "memory");
        } else {
            XB_SPIN(xb_ld(&bar[XB_XGEN(b.x)]) == gen, bar);
            __builtin_amdgcn_fence(__ATOMIC_ACQUIRE, "agent");
            asm volatile("s_waitcnt vmcnt(0)" ::: "memory");
        }
    }
    __syncthreads();
}

struct Args { const float* in[18]; float* out; unsigned char* ws; int ph_lo, ph_hi; };
constexpr int N_PHASES = 24;

__global__ void __launch_bounds__(NWAVES * 64, 2) hybrid_fwd(Args args) {
    extern __shared__ __attribute__((aligned(16))) unsigned char lds[];
    cg::grid_group grid = cg::this_grid();
    LAS unsigned char* ldsl = (LAS unsigned char*)lds;
    const int tid = threadIdx.x, lane = tid & 63, wave = __builtin_amdgcn_readfirstlane(tid >> 6);
    const int G = gridDim.x, gw = blockIdx.x * NWAVES + wave, NGW = G * NWAVES;
    unsigned char* ws = args.ws;
    float* rope = (float*)(ws + WS_ROPE);
    bf16_t* KMH = (bf16_t*)(ws + WS_KMH); bf16_t* KML = (bf16_t*)(ws + WS_KML); float* LSE0 = (float*)(ws + WS_LSE); float* LSEA = (float*)(ws + WS_LSE + 2 * MiB); float* LSEB = (float*)(ws + WS_LSE + 4 * MiB); unsigned* SEL = (unsigned*)(ws + WS_LSE + 6 * MiB);
    bf16_t* WIN[4] = {(bf16_t*)(ws + WS_WIN0), (bf16_t*)(ws + WS_WIN1), (bf16_t*)(ws + WS_WIN2), (bf16_t*)(ws + WS_WIN3)};
    bf16_t* WOUT = (bf16_t*)(ws + WS_WOUT);
    bf16_t* XN = (bf16_t*)(ws + WS_XN); bf16_t* YG = (bf16_t*)(ws + WS_YG); bf16_t* QKV = (bf16_t*)(ws + WS_QKV); bf16_t* PA = (bf16_t*)(ws + WS_QKV + 256 * MiB); bf16_t* PB = XN;
    float* X = args.out;
    LAS char* vst = (LAS char*)(ldsl + wave * 16384);
    const int lo = args.ph_lo, hi = args.ph_hi;
#define IN(k) (lo <= (k) && (k) < hi)
    if (tid < 64) ((LAS unsigned*)(ldsl + MISC_OFF))[tid] = 0u;
    __syncthreads();
    (void)xcd_barrier_post((unsigned*)(ws + WS_BAR), (volatile LAS unsigned*)(ldsl + MISC_OFF) + 8);
    int ph = 0;
#define PH_IF if (IN(ph))
#define PH_END do { if (IN(ph) && IN(ph + 1)) { if (ph == 0) grid.sync(); else { XcdBarrier bar_; { unsigned* bp_ = (unsigned*)(args.ws + WS_BAR); asm volatile("" : "+s"(bp_)); bar_.bar = bp_; } bar_.x = xb_xcc_id(); bar_.st = (volatile LAS unsigned*)(ldsl + MISC_OFF) + 8; xcd_barrier(bar_); } } ++ph; } while (0)

    PH_IF {
        LAS float* scr = (LAS float*)(ldsl + wave * 16384);
        constexpr int C1 = 2048, C2 = 4096, C3 = 5376, C4 = 10496, C5 = 11008, C6 = 11520, C7 = 12032, C8 = 12544;
        for (int it = gw; it < C8; it += NGW) {
            const int mi = (it >= C1) + (it >= C2) + (it >= C3) + (it >= C4) + (it >= C5) + (it >= C6) + (it >= C7);
            const int base = mi == 0 ? 0 : mi == 1 ? C1 : mi == 2 ? C2 : mi == 3 ? C3 : mi == 4 ? C4 : mi == 5 ? C5 : mi == 6 ? C6 : C7;
            const int N = mi < 2 ? 4096 : mi == 2 ? 2560 : mi == 3 ? 10240 : 1024;
            const float* W = mi == 0 ? args.in[1] : mi == 1 ? args.in[5] : mi == 2 ? args.in[9] : mi == 3 ? args.in[14] : mi == 4 ? args.in[2] : mi == 5 ? args.in[6] : mi == 6 ? args.in[11] : args.in[15];
            const size_t woff = mi == 0 ? WS_WIN0 : mi == 1 ? WS_WIN1 : mi == 2 ? WS_WIN2 : mi == 3 ? WS_WIN3 : WS_WOUT + (size_t)(mi - 4) * 2 * MiB;
            transpose_item(W, 1024, N, (bf16_t*)(ws + woff), scr, it - base, lane);
        }
        const int gt = blockIdx.x * (NWAVES * 64) + tid, NGT = G * NWAVES * 64;
        for (int idx = gt; idx < SEQ * 8; idx += NGT) { const int pos = idx >> 3, i = idx & 7;
            const float inv = (float)pow(500000.0, -(double)i / 8.0); const float ang = (float)pos * inv;
            double sn, cs; sincos((double)ang, &sn, &cs); rope[pos * 16 + i] = (float)cs; rope[pos * 16 + 8 + i] = (float)sn; }
        const float* x = args.in[0];
        for (size_t idx = gt; idx < (size_t)MTOK * DM / 8; idx += (size_t)NGT * 4) {
            f32x4 a[4], c[4];
#pragma unroll
            for (int r = 0; r < 4; ++r) { if (idx + (size_t)r * NGT < (size_t)MTOK * DM / 8) { a[r] = *(const f32x4*)(x + (idx + (size_t)r * NGT) * 8); c[r] = *(const f32x4*)(x + (idx + (size_t)r * NGT) * 8 + 4); } }
#pragma unroll
            for (int r = 0; r < 4; ++r) if (idx + (size_t)r * NGT < (size_t)MTOK * DM / 8) { u32x4 w; w.x = pk2(a[r][0], a[r][1]); w.y = pk2(a[r][2], a[r][3]); w.z = pk2(c[r][0], c[r][1]); w.w = pk2(c[r][2], c[r][3]); *(u32x4*)(XN + (idx + (size_t)r * NGT) * 8) = w; } }
    }
    PH_END;

#define GEMM_IN(layer_, A_, Mrows_, N_) do { pg8::Gemm gg{(A_), WIN[layer_], (Mrows_), (N_), DM}; pg8::StaticOrder S; S.init((Mrows_), (N_), G, (int)blockIdx.x); \
        pg8::EpiIn E{QKV, (N_), (layer_), rope}; pg8::gemm_phase<pg8::EpiIn, pg8::StaticOrder, true, true>(ldsl, gg, S, E); } while (0)
#define GEMM_OUT(layer_, Xsrc_) do { pg8::Gemm gg{YG, WOUT + (size_t)(layer_) * 1024 * 1024, MTOK, DM, DM}; pg8::StaticOrder S; S.init(MTOK, DM, G, (int)blockIdx.x); \
        pg8::EpiOut E{(Xsrc_), X, DN_ALPHA}; pg8::gemm_phase<pg8::EpiOut, pg8::StaticOrder, true, true>(ldsl, gg, S, E); } while (0)
#define LN_PHASE(gidx_, bidx_, write_xn_) do { const float* gp = args.in[gidx_]; const float* bp = args.in[bidx_]; \
        f32x4 gv[4], bv[4]; _Pragma("unroll") for (int jj = 0; jj < 4; ++jj) { gv[jj] = *(const f32x4*)(gp + 4 * lane + 256 * jj); bv[jj] = *(const f32x4*)(bp + 4 * lane + 256 * jj); } \
        for (int r = gw; r < MTOK; r += NGW) { float* xr = X + (size_t)r * DM + 4 * lane; f32x4 v[4]; float s = 0.f; \
            _Pragma("unroll") for (int jj = 0; jj < 4; ++jj) { v[jj] = *(const f32x4*)(xr + 256 * jj); s += (v[jj][0] + v[jj][1]) + (v[jj][2] + v[jj][3]); } \
            const float mean = wave_sum(s) * (1.f / DM); float s2 = 0.f; \
            _Pragma("unroll") for (int jj = 0; jj < 4; ++jj) { v[jj] = v[jj] - mean; s2 += (v[jj][0] * v[jj][0] + v[jj][1] * v[jj][1]) + (v[jj][2] * v[jj][2] + v[jj][3] * v[jj][3]); } \
            const float rstd = 1.f / sqrtf(wave_sum(s2) * (1.f / DM) + LN_EPS); \
            _Pragma("unroll") for (int jj = 0; jj < 4; ++jj) { v[jj] = v[jj] * rstd * gv[jj] + bv[jj]; *(f32x4*)(xr + 256 * jj) = v[jj]; \
                if (write_xn_) { u32x2 w; w.x = pk2(v[jj][0], v[jj][1]); w.y = pk2(v[jj][2], v[jj][3]); *(u32x2*)(XN + (size_t)r * DM + 4 * lane + 256 * jj) = w; } } } } while (0)

    PH_IF GEMM_IN(0, XN, MTOK, 4096);
    PH_END;
    PH_IF { for (int u = gw; u < NBATCH * 16 * (SEQ / QW); u += NGW) { const int bh = u & 63, q64 = u >> 6; sb_unit(QKV, YG, bh >> 4, bh & 15, q64 * QW, vst, lane); } }
    PH_END;
    PH_IF GEMM_OUT(0, args.in[0]);
    PH_END;
    PH_IF LN_PHASE(3, 4, true);
    PH_END;
    PH_IF GEMM_IN(1, XN, MTOK, 4096);
    PH_END;
    PH_IF {
        for (int u = gw; u < NBATCH * 16 * 32; u += NGW) { const int j = u & 31, bh = u >> 5, b = bh >> 4, h = bh & 15;
            const bf16_t* kp = QKV + (size_t)(b * SEQ + j * 256 + (lane >> 3)) * 4096 + 1024 + h * 64 + 8 * (lane & 7);
            float a[8] = {0.f, 0.f, 0.f, 0.f, 0.f, 0.f, 0.f, 0.f};
#pragma unroll 4
            for (int i = 0; i < 32; ++i) { const u32x4 w = *(const u32x4*)(kp + (size_t)(8 * i) * 4096);
                a[0] += bflo(w.x); a[1] += bfhi(w.x); a[2] += bflo(w.y); a[3] += bfhi(w.y); a[4] += bflo(w.z); a[5] += bfhi(w.z); a[6] += bflo(w.w); a[7] += bfhi(w.w); }
#pragma unroll
            for (int e = 0; e < 8; ++e) { a[e] += __shfl_xor(a[e], 8); a[e] += __shfl_xor(a[e], 16); a[e] += __shfl_xor(a[e], 32); a[e] *= (1.f / 256.f); }
            if (lane < 8) { unsigned hh[8], ll[8];
#pragma unroll
                for (int e = 0; e < 8; ++e) { hh[e] = f2bf(a[e]); ll[e] = f2bf(a[e] - __builtin_bit_cast(float, hh[e] << 16)); }
                u32x4 wh, wl; wh.x = hh[0] | (hh[1] << 16); wh.y = hh[2] | (hh[3] << 16); wh.z = hh[4] | (hh[5] << 16); wh.w = hh[6] | (hh[7] << 16);
                wl.x = ll[0] | (ll[1] << 16); wl.y = ll[2] | (ll[3] << 16); wl.z = ll[4] | (ll[5] << 16); wl.w = ll[6] | (ll[7] << 16);
                *(u32x4*)(KMH + (size_t)u * 64 + 8 * lane) = wh; *(u32x4*)(KML + (size_t)u * 64 + 8 * lane) = wl; }
        }
    }
    PH_END;
    PH_IF {
        for (int u = gw; u < NBATCH * 16 * (SEQ / QW); u += NGW) { const int bh = u & 63; int q64 = u >> 6; if ((q64 >> 5) & 1) q64 = (q64 & ~31) + 31 - (q64 & 31);
            moba_own_unit(QKV, KMH, KML, YG, LSE0, SEL, bh >> 4, bh & 15, q64 * QW, vst, lane); }
    }
    PH_END;
    PH_IF {
        const int c = (int)blockIdx.x;
        for (int k = 0;; ++k) { const int U = k * G + ((k & 1) ? (G - 1 - c) : c); if (k * G >= 31 * 64) break; if (U >= 31 * 64) continue;
            const int j = U >> 6, bh = U & 63; moba_routed_unit(QKV, SEL, YG, LSE0, PA, LSEA, PB, LSEB, bh >> 4, bh & 15, j, ldsl, tid); }
        __syncthreads();
    }
    PH_END;
    PH_IF {
        const int gt = blockIdx.x * (NWAVES * 64) + tid, NGT = G * NWAVES * 64;
        for (int idx = gt; idx < MTOK * 128; idx += NGT) { const int row = idx >> 7, c8 = (idx & 127) * 8, h = c8 >> 6, b = row >> 13, t = row & (SEQ - 1);
            const int nsel = __builtin_popcount(SEL[(size_t)(b * 16 + h) * SEQ + t]);
            const float l0 = LSE0[(size_t)row * 16 + h], l1 = nsel >= 2 ? LSEA[(size_t)row * 16 + h] : -__builtin_inff(), l2 = nsel >= 3 ? LSEB[(size_t)row * 16 + h] : -__builtin_inff();
            const float mx = fmaxf(l0, fmaxf(l1, l2)); float w0 = fexp2((l0 - mx) * LOG2E), w1 = fexp2((l1 - mx) * LOG2E), w2 = fexp2((l2 - mx) * LOG2E);
            const float inv = 1.f / (w0 + w1 + w2); w0 *= inv; w1 *= inv; w2 *= inv;
            const size_t off = (size_t)row * DM + c8; const u32x4 zero = {0u, 0u, 0u, 0u};
            const u32x4 a = *(const u32x4*)(YG + off), bq = nsel >= 2 ? *(const u32x4*)(PA + off) : zero, cq = nsel >= 3 ? *(const u32x4*)(PB + off) : zero, z = *(const u32x4*)(QKV + (size_t)row * 4096 + 3072 + c8);
            u32x4 w;
            w.x = pk2((w0 * bflo(a.x) + w1 * bflo(bq.x) + w2 * bflo(cq.x)) * bflo(z.x), (w0 * bfhi(a.x) + w1 * bfhi(bq.x) + w2 * bfhi(cq.x)) * bfhi(z.x));
            w.y = pk2((w0 * bflo(a.y) + w1 * bflo(bq.y) + w2 * bflo(cq.y)) * bflo(z.y), (w0 * bfhi(a.y) + w1 * bfhi(bq.y) + w2 * bfhi(cq.y)) * bfhi(z.y));
            w.z = pk2((w0 * bflo(a.z) + w1 * bflo(bq.z) + w2 * bflo(cq.z)) * bflo(z.z), (w0 * bfhi(a.z) + w1 * bfhi(bq.z) + w2 * bfhi(cq.z)) * bfhi(z.z));
            w.w = pk2((w0 * bflo(a.w) + w1 * bflo(bq.w) + w2 * bflo(cq.w)) * bflo(z.w), (w0 * bfhi(a.w) + w1 * bfhi(bq.w) + w2 * bfhi(cq.w)) * bfhi(z.w));
            *(u32x4*)(YG + off) = w; }
    }
    PH_END;
    PH_IF GEMM_OUT(1, X);
    PH_END;
    PH_IF LN_PHASE(7, 8, true);
    PH_END;
    PH_IF GEMM_IN(2, XN, MTOK, 2560);
    PH_END;
    PH_IF {
        band_lds_phase<0>(QKV, YG, nullptr, args.in[10], ldsl, G, tid);
    }
    PH_END;
    PH_IF GEMM_OUT(2, X);
    PH_END;
    PH_IF LN_PHASE(12, 13, true);
    PH_END;
#pragma unroll 1
    for (int half = 0; half < 2; ++half) {
        PH_IF GEMM_IN(3, XN + (size_t)half * 16384 * DM, 16384, 10240);
        PH_END;
        PH_IF {
            band_lds_phase<1>(QKV, YG, LSE0, nullptr, ldsl, G, tid);
        }
        PH_END;
        PH_IF {
            const int gt = blockIdx.x * (NWAVES * 64) + tid, NGT = G * NWAVES * 64;
            for (int idx = gt; idx < 16384 * 128; idx += NGT) { const int row = idx >> 7, c8 = (idx & 127) * 8, h = c8 >> 6;
                const float l0 = LSE0[(size_t)row * 16 + h], l1 = LSE0[(size_t)(16384 + row) * 16 + h], l2 = LSE0[(size_t)(32768 + row) * 16 + h];
                const float mx = fmaxf(l0, fmaxf(l1, l2)); float w0 = fexp2((l0 - mx) * LOG2E), w1 = fexp2((l1 - mx) * LOG2E), w2 = fexp2((l2 - mx) * LOG2E);
                const float inv = 1.f / (w0 + w1 + w2); w0 *= inv; w1 *= inv; w2 *= inv;
                const bf16_t* rp = QKV + (size_t)row * 10240 + c8;
                const u32x4 a = *(const u32x4*)rp, bq = *(const u32x4*)(rp + 3072), cq = *(const u32x4*)(rp + 6144), z = *(const u32x4*)(rp + 9216);
                u32x4 w;
                w.x = pk2((w0 * bflo(a.x) + w1 * bflo(bq.x) + w2 * bflo(cq.x)) * bflo(z.x), (w0 * bfhi(a.x) + w1 * bfhi(bq.x) + w2 * bfhi(cq.x)) * bfhi(z.x));
                w.y = pk2((w0 * bflo(a.y) + w1 * bflo(bq.y) + w2 * bflo(cq.y)) * bflo(z.y), (w0 * bfhi(a.y) + w1 * bfhi(bq.y) + w2 * bfhi(cq.y)) * bfhi(z.y));
                w.z = pk2((w0 * bflo(a.z) + w1 * bflo(bq.z) + w2 * bflo(cq.z)) * bflo(z.z), (w0 * bfhi(a.z) + w1 * bfhi(bq.z) + w2 * bfhi(cq.z)) * bfhi(z.z));
                w.w = pk2((w0 * bflo(a.w) + w1 * bflo(bq.w) + w2 * bflo(cq.w)) * bflo(z.w), (w0 * bfhi(a.w) + w1 * bfhi(bq.w) + w2 * bfhi(cq.w)) * bfhi(z.w));
                *(u32x4*)(YG + ((size_t)half * 16384 + row) * DM + c8) = w; }
        }
        PH_END;
    }
    PH_IF GEMM_OUT(3, X);
    PH_END;
    PH_IF LN_PHASE(16, 17, false);
#undef IN
#undef PH_IF
#undef PH_END
}

#ifndef N_LAUNCH_MODE
#define N_LAUNCH_MODE 1
#endif
extern "C" void kernel_launch(void* const* d_in, const int* in_sizes, int n_in, void* d_out, int out_size, void* d_ws, size_t ws_size, hipStream_t stream) {
    static int grid = 0;
    if (grid == 0) {
        if (n_in != 18 || in_sizes[0] != MTOK * DM || out_size != MTOK * DM || ws_size < WS_END) { fprintf(stderr, "kernel_launch: unexpected shapes / workspace (n_in %d, ws %zu)\n", n_in, ws_size); grid = -1; return; }
        int dev = 0, cus = 0, per_cu = 0;
        hipGetDevice(&dev); hipDeviceGetAttribute(&cus, hipDeviceAttributeMultiprocessorCount, dev);
        hipFuncSetAttribute((const void*)hybrid_fwd, hipFuncAttributeMaxDynamicSharedMemorySize, LDS_BYTES);
        hipOccupancyMaxActiveBlocksPerMultiprocessor(&per_cu, (const void*)hybrid_fwd, NWAVES * 64, LDS_BYTES);
        (void)hipGetLastError();
        if (per_cu < 1) per_cu = 1;
        grid = cus;
    }
    if (grid < 0) return;
    Args a{};
    for (int i = 0; i < 18; ++i) a.in[i] = (const float*)d_in[i];
    a.out = (float*)d_out; a.ws = (unsigned char*)d_ws;
    if (hipMemsetAsync((char*)d_ws + WS_BAR, 0, BAR_BYTES, stream) != hipSuccess) { fprintf(stderr, "kernel_launch: memset of the barrier words failed\n"); return; }
#if N_LAUNCH_MODE == 1
    a.ph_lo = 0; a.ph_hi = N_PHASES;
    void* params[] = {&a};
    hipError_t e = hipLaunchCooperativeKernel((const void*)hybrid_fwd, dim3(grid), dim3(NWAVES * 64), params, LDS_BYTES, stream);
    if (e != hipSuccess) fprintf(stderr, "cooperative launch failed: %s (grid %d)\n", hipGetErrorString(e), grid);
#else
    for (int p = 0; p < N_PHASES; ++p) { a.ph_lo = p; a.ph_hi = p + 1; hipLaunchKernelGGL(hybrid_fwd, dim3(grid), dim3(NWAVES * 64), LDS_BYTES, stream, a); }
#endif
}
```

```cpp
#include <hip/hip_runtime.h>
#include <hip/hip_cooperative_groups.h>
#include <cstdio>
#include <cstdint>
#include <cmath>
namespace cg = cooperative_groups;
namespace pg8 {
#define PG8_LAS __attribute__((address_space(3)))
typedef unsigned short bf16_t;
typedef short bf16x8 __attribute__((ext_vector_type(8)));
typedef float f32x4 __attribute__((ext_vector_type(4)));
typedef unsigned u32x4 __attribute__((ext_vector_type(4)));
constexpr int BM = 256, BK = 64, HALF = 128, HTB = HALF * BK * 2  , STAGE_BYTES = 8 * HTB, NXCD = 8, WGM = 8;

__host__ __device__ __forceinline__ int lds_byte(int r, int c) { const int st = (r >> 4) * 2 + (c >> 5), rr = r & 15, cc = c & 31, ob = rr * 64 + cc * 2; return st * 1024 + (ob ^ (((ob >> 9) & 1) << 5)); }
__host__ __device__ __forceinline__ void stage_rc(int b, int& R, int& C) { const int st = b / 1024, sb = b % 1024, swz = sb ^ (((sb >> 9) & 1) << 5); R = (st >> 1) * 16 + swz / 64; C = (st & 1) * 32 + (swz % 64) / 2; }
__host__ __device__ __forceinline__ int perm32(int rho) { const int n = rho >> 4, i = rho & 15; return 8 * (i >> 2) + 4 * n + (i & 3); }

struct Unit { int pm, pn; };
struct Gemm { const bf16_t* A; const bf16_t* Bt; int M, N, K; };

struct StaticOrder {
    int nM, nN, nwg, G, c;
    __host__ __device__ void init(int M, int N, int G_, int c_) { nM = M / BM; nN = N / BM; nwg = nM * nN; G = G_; c = c_; }
    __host__ __device__ bool next(int i, Unit& u) const {
        const long L = (long)i * G + c; if (L >= nwg) return false;
        int wgid = (int)L; { const int q = nwg / NXCD, r = nwg % NXCD, xcd = wgid % NXCD, off = wgid / NXCD; wgid = (xcd < r ? xcd * (q + 1) : r * (q + 1) + (xcd - r) * q) + off; }
        const int nig = WGM * nN, gid = wgid / nig, fm = gid * WGM, gsz = (nM - fm) < WGM ? (nM - fm) : WGM;
        u.pm = fm + ((wgid % nig) % gsz); u.pn = (wgid % nig) / gsz; return true;
    }
    __device__ __forceinline__ void a_ready(const Unit&) const {}
    __device__ __forceinline__ void done(const Unit&) const {}
};

__device__ __forceinline__ unsigned cvt_pk_bf16(float lo, float hi) { unsigned r; asm volatile("v_cvt_pk_bf16_f32 %0, %1, %2" : "=v"(r) : "v"(lo), "v"(hi)); return r; }
struct EpiIn {
    static constexpr bool PERM = true, AFTER_DRAIN = false;
    bf16_t* O; int ldc; int layer; const float* rope;
    __device__ __forceinline__ void operator()(const f32x4 (&acc)[2][2][4][2], const Unit& u, int wr, int wc, int fr, int fq) const {
        const int colt = u.pn * BM;
        int kind;
        if (layer == 0) { const int part = colt >> 10; kind = part == 0 ? 3 : (part == 3 ? 4 : 0); }
        else if (layer == 1) { const int part = colt >> 10; kind = part == 0 ? 2 : (part == 1 ? 1 : (part == 3 ? 4 : 0)); }
        else if (layer == 2) { kind = colt < 1024 ? 2 : (colt == 1024 ? 1 : (colt == 1280 ? 0 : 4)); }
        else { const int part = colt >> 10; const int t3 = part % 3; kind = part == 9 ? 4 : (t3 == 0 ? 2 : (t3 == 1 ? 1 : 0)); }
        const bool rope_on = (kind == 1 || kind == 2) && ((wc & 1) == 0);
        const float sc = kind == 2 ? 0.125f * 1.4426950408889634f : (kind == 3 ? 0.125f : 1.0f);
        const int row0 = u.pm * BM + wr * 64 + fr, col0 = colt + wc * 32 + 8 * fq;
        const bool hm = layer == 3; const size_t rstride = hm ? 64 : (size_t)ldc; const size_t bjoff = hm ? (size_t)2 * 8192 * 64 : (size_t)HALF;
        bf16_t* lanebase = hm ? O + ((size_t)((((colt >> 10) * 2 + (row0 >> 13)) * 16 + ((colt & 1023) >> 6) + (wc >> 1)) * 8192) + (row0 & 8191)) * 64 + 32 * (wc & 1) + 8 * fq : O + (size_t)row0 * ldc + col0;
#pragma unroll
        for (int ai = 0; ai < 2; ++ai)
#pragma unroll
            for (int m = 0; m < 4; ++m) {
                const int row = row0 + ai * HALF + m * 16;
                f32x4 c0 = {1.f, 1.f, 1.f, 1.f}, c1 = c0, s0 = {0.f, 0.f, 0.f, 0.f}, s1 = s0;
                if (rope_on) { const float* rp = rope + (size_t)(row & 8191) * 16; c0 = *(const f32x4*)rp; c1 = *(const f32x4*)(rp + 4); s0 = *(const f32x4*)(rp + 8); s1 = *(const f32x4*)(rp + 12);
                    if (fq == 0) { s0 = -s0; s1 = -s1; } if (fq >= 2) { c0 = (f32x4){1.f, 1.f, 1.f, 1.f}; c1 = c0; s0 = (f32x4){0.f, 0.f, 0.f, 0.f}; s1 = s0; } }
                bf16_t* rowp = lanebase + (size_t)(ai * HALF + m * 16) * rstride;
#pragma unroll
                for (int bj = 0; bj < 2; ++bj) {
                    f32x4 v0 = acc[ai][bj][m][0], v1 = acc[ai][bj][m][1];
                    if (rope_on) {
                        f32x4 o0, o1;
#pragma unroll
                        for (int e = 0; e < 4; ++e) { o0[e] = __shfl_xor(v0[e], 16); o1[e] = __shfl_xor(v1[e], 16); }
                        v0 = v0 * c0 + o0 * s0; v1 = v1 * c1 + o1 * s1;
                    }
                    v0 = v0 * sc; v1 = v1 * sc;
                    if (kind == 4) {
#pragma unroll
                        for (int e = 0; e < 4; ++e) { v0[e] = v0[e] * __builtin_amdgcn_rcpf(1.f + __builtin_amdgcn_exp2f(-1.4426950408889634f * v0[e])); v1[e] = v1[e] * __builtin_amdgcn_rcpf(1.f + __builtin_amdgcn_exp2f(-1.4426950408889634f * v1[e])); }
                    }
                    u32x4 w; w.x = cvt_pk_bf16(v0[0], v0[1]); w.y = cvt_pk_bf16(v0[2], v0[3]); w.z = cvt_pk_bf16(v1[0], v1[1]); w.w = cvt_pk_bf16(v1[2], v1[3]);
                    *(u32x4*)(rowp + bj * bjoff) = w;
                }
            }
    }
};
struct EpiOut {
    static constexpr bool PERM = false, AFTER_DRAIN = false;
    const float* X; float* T; float alpha;
    __device__ __forceinline__ void operator()(const f32x4 (&acc)[2][2][4][2], const Unit& u, int wr, int wc, int fr, int fq) const {
        const int row0 = u.pm * BM + wr * 64 + fr, col0 = u.pn * BM + wc * 32 + 4 * fq;
#pragma unroll
        for (int ai = 0; ai < 2; ++ai)
#pragma unroll
            for (int m = 0; m < 4; ++m) {
                const size_t ro = (size_t)(row0 + ai * HALF + m * 16) * 1024 + col0;
#pragma unroll
                for (int bj = 0; bj < 2; ++bj)
#pragma unroll
                    for (int n = 0; n < 2; ++n) { const size_t o = ro + bj * HALF + 16 * n; const f32x4 x = *(const f32x4*)(X + o); *(f32x4*)(T + o) = x * alpha + acc[ai][bj][m][n]; }
            }
    }
};
template <class Epi, class Sched, bool ALIGN_EPI = false, bool SP2 = false>
__device__ __forceinline__ void gemm_phase(PG8_LAS unsigned char* lds, const Gemm g, const Sched& S, const Epi& E) {
    int tid_ = threadIdx.x; asm volatile("" : "+v"(tid_));
    const int tid = tid_, wid = __builtin_amdgcn_readfirstlane(tid >> 6), lane = tid & 63, wr = wid >> 2, wc = wid & 3, fr = lane & 15, fq = lane >> 4;
    const int K = g.K, nt = K / BK;
    unsigned voffA[2], voffB[2];
#pragma unroll
    for (int i = 0; i < 2; ++i) { int R, C; stage_rc(tid * 16 + i * 8192, R, C); const int Rb = Epi::PERM ? ((R & ~31) + perm32(R & 31)) : R;
        voffA[i] = (unsigned)(R * K + C) * 2u; voffB[i] = (unsigned)(Rb * K + C) * 2u; }
    const size_t kstep = (size_t)(BK * 2);
    const size_t hstep = (size_t)HALF * K * 2;
    const size_t tstep = 2 * hstep;
    const unsigned ldsw = (unsigned)wid * 1024u;
    const int aoff = lds_byte(wr * 64 + fr, fq * 8), boff = lds_byte(wc * 32 + fr, fq * 8);
#define PG8_SA(b, h) (((b) * 2 + (h)) * HTB)
#define PG8_SB(b, h) ((4 + (b) * 2 + (h)) * HTB)
#define PG8_STAGE(bufoff, gbase, voff) do { _Pragma("unroll") for (int _i = 0; _i < 2; ++_i) \
        __builtin_amdgcn_global_load_lds((const unsigned*)((const char*)(gbase) + (voff)[_i]), (PG8_LAS unsigned*)(lds + (bufoff) + ldsw + _i * 8192), 16, 0, 0); } while (0)
#define PG8_LDA(dst, b, h) do { _Pragma("unroll") for (int m = 0; m < 4; ++m) _Pragma("unroll") for (int k = 0; k < 2; ++k) dst[m][k] = *(const PG8_LAS bf16x8*)(lds + PG8_SA(b, h) + aoff + m * 2048 + k * 1024); } while (0)
#define PG8_LDB(dst, b, h) do { _Pragma("unroll") for (int n = 0; n < 2; ++n) _Pragma("unroll") for (int k = 0; k < 2; ++k) dst[n][k] = *(const PG8_LAS bf16x8*)(lds + PG8_SB(b, h) + boff + n * 2048 + k * 1024); } while (0)
#define PG8_MMA(ai, bj, At, Bt) do { __builtin_amdgcn_s_setprio(1); _Pragma("unroll") for (int m = 0; m < 4; ++m) _Pragma("unroll") for (int n = 0; n < 2; ++n) _Pragma("unroll") for (int k = 0; k < 2; ++k) \
        acc[ai][bj][m][n] = __builtin_amdgcn_mfma_f32_16x16x32_bf16(Bt[n][k], At[m][k], acc[ai][bj][m][n], 0, 0, 0); __builtin_amdgcn_s_setprio(0); } while (0)
#define PG8_WAIT_V(n) asm volatile("s_waitcnt vmcnt(" #n ")" ::: "memory")
#define PG8_WAIT_L(n) asm volatile("s_waitcnt lgkmcnt(" #n ")" ::: "memory")
#define PG8_BAR __builtin_amdgcn_s_barrier()
#define PG8_SCHED __builtin_amdgcn_sched_barrier(0)
    Unit cur, nxt; int ui = 0;
    if (!S.next(0, cur)) return;
    f32x4 acc[2][2][4][2];
#pragma unroll
    for (int a = 0; a < 2; ++a)
#pragma unroll
        for (int b = 0; b < 2; ++b)
#pragma unroll
            for (int m = 0; m < 4; ++m)
#pragma unroll
                for (int n = 0; n < 2; ++n) acc[a][b][m][n] = (f32x4){0.f, 0.f, 0.f, 0.f};
    bf16x8 At[4][2], B0[2][2], B1[2][2];
    const char* cA = (const char*)g.A + (size_t)cur.pm * tstep; const char* cB = (const char*)g.Bt + (size_t)cur.pn * tstep;
    S.a_ready(cur);
    if constexpr (SP2) {
        PG8_STAGE(PG8_SB(0, 0), cB, voffB); PG8_STAGE(PG8_SB(0, 1), cB + hstep, voffB); PG8_STAGE(PG8_SA(0, 0), cA, voffA); PG8_STAGE(PG8_SA(0, 1), cA + hstep, voffA);
        if (wr == 1) PG8_BAR;
        PG8_WAIT_V(2); PG8_BAR;
        PG8_STAGE(PG8_SB(1, 0), cB + kstep, voffB); PG8_STAGE(PG8_SA(1, 0), cA + kstep, voffA); PG8_STAGE(PG8_SB(1, 1), cB + hstep + kstep, voffB);
        PG8_WAIT_V(6); PG8_BAR;
    } else {
        PG8_STAGE(PG8_SB(0, 0), cB, voffB); PG8_STAGE(PG8_SA(0, 0), cA, voffA); PG8_STAGE(PG8_SB(0, 1), cB + hstep, voffB); PG8_STAGE(PG8_SA(0, 1), cA + hstep, voffA);
        if (wr == 1) PG8_BAR;
        PG8_WAIT_V(4); PG8_BAR;
        PG8_STAGE(PG8_SB(1, 0), cB + kstep, voffB); PG8_STAGE(PG8_SA(1, 0), cA + kstep, voffA); PG8_STAGE(PG8_SB(1, 1), cB + hstep + kstep, voffB);
        PG8_WAIT_V(6); PG8_BAR;
    }
    for (;;) {
        const bool has_next = S.next(ui + 1, nxt);
        const char* nA = has_next ? (const char*)g.A + (size_t)nxt.pm * tstep : cA; const char* nB = has_next ? (const char*)g.Bt + (size_t)nxt.pn * tstep : cB;
        for (int t = 0; t < nt; t += 2) {
            const bool last = (t == nt - 2);
            const char* a1 = cA + (size_t)(t + 1) * kstep;
            const char* a2 = last ? nA : cA + (size_t)(t + 2) * kstep; const char* b2 = last ? nB : cB + (size_t)(t + 2) * kstep;
            const char* a3 = a2 + kstep; const char* b3 = b2 + kstep;
            if (last && has_next) S.a_ready(nxt);
            if constexpr (SP2) {
            PG8_LDB(B0, 0, 0); PG8_LDB(B1, 0, 1); PG8_SCHED; PG8_LDA(At, 0, 0); PG8_STAGE(PG8_SA(1, 1), a1 + hstep, voffA);
            PG8_WAIT_V(8); PG8_WAIT_L(0); PG8_BAR; PG8_MMA(0, 0, At, B0); PG8_MMA(0, 1, At, B1); PG8_BAR; PG8_SCHED;
            PG8_LDA(At, 0, 1); PG8_STAGE(PG8_SB(0, 0), b2, voffB); PG8_STAGE(PG8_SB(0, 1), b2 + hstep, voffB); PG8_STAGE(PG8_SA(0, 0), a2, voffA);
            PG8_WAIT_V(8); PG8_WAIT_L(0); PG8_BAR; PG8_MMA(1, 0, At, B0); PG8_MMA(1, 1, At, B1); PG8_BAR; PG8_SCHED;
            PG8_LDB(B0, 1, 0); PG8_LDB(B1, 1, 1); PG8_SCHED; PG8_LDA(At, 1, 0); PG8_STAGE(PG8_SA(0, 1), a2 + hstep, voffA);
            PG8_WAIT_V(8); PG8_WAIT_L(0); PG8_BAR; PG8_MMA(0, 0, At, B0); PG8_MMA(0, 1, At, B1); PG8_BAR; PG8_SCHED;
            PG8_LDA(At, 1, 1); PG8_STAGE(PG8_SB(1, 0), b3, voffB); PG8_STAGE(PG8_SB(1, 1), b3 + hstep, voffB); PG8_STAGE(PG8_SA(1, 0), a3, voffA);
            PG8_WAIT_V(8); PG8_WAIT_L(0); PG8_BAR; PG8_MMA(1, 0, At, B0); PG8_MMA(1, 1, At, B1); PG8_BAR; PG8_SCHED;
            } else {
            PG8_LDB(B0, 0, 0); PG8_SCHED; PG8_LDA(At, 0, 0); PG8_STAGE(PG8_SA(1, 1), a1 + hstep, voffA);
            PG8_WAIT_L(8); PG8_BAR; PG8_WAIT_L(0); PG8_MMA(0, 0, At, B0); PG8_BAR; PG8_SCHED;
            PG8_LDB(B1, 0, 1); PG8_STAGE(PG8_SB(0, 0), b2, voffB);
            PG8_BAR; PG8_WAIT_L(0); PG8_MMA(0, 1, At, B1); PG8_BAR;
            PG8_LDA(At, 0, 1); PG8_STAGE(PG8_SA(0, 0), a2, voffA);
            PG8_BAR; PG8_WAIT_L(0); PG8_MMA(1, 0, At, B0); PG8_BAR; PG8_SCHED;
            PG8_STAGE(PG8_SB(0, 1), b2 + hstep, voffB);
            PG8_WAIT_V(6); PG8_BAR; PG8_MMA(1, 1, At, B1); PG8_BAR;
            PG8_LDB(B0, 1, 0); PG8_SCHED; PG8_LDA(At, 1, 0); PG8_STAGE(PG8_SA(0, 1), a2 + hstep, voffA);
            PG8_WAIT_L(8); PG8_BAR; PG8_WAIT_L(0); PG8_MMA(0, 0, At, B0); PG8_BAR; PG8_SCHED;
            PG8_LDB(B1, 1, 1); PG8_STAGE(PG8_SB(1, 0), b3, voffB);
            PG8_BAR; PG8_WAIT_L(0); PG8_MMA(0, 1, At, B1); PG8_BAR;
            PG8_LDA(At, 1, 1); PG8_STAGE(PG8_SA(1, 0), a3, voffA);
            PG8_BAR; PG8_WAIT_L(0); PG8_MMA(1, 0, At, B0); PG8_BAR; PG8_SCHED;
            PG8_STAGE(PG8_SB(1, 1), b3 + hstep, voffB);
            PG8_WAIT_V(6); PG8_BAR; PG8_MMA(1, 1, At, B1); PG8_BAR;
            }
        }
        if constexpr (ALIGN_EPI) { if (wr == 0) PG8_BAR; }
        if constexpr (!Epi::AFTER_DRAIN) { E(acc, cur, wr, wc, fr, fq); S.done(cur); }
        if (!has_next) break;
#pragma unroll
        for (int a = 0; a < 2; ++a)
#pragma unroll
            for (int b = 0; b < 2; ++b)
#pragma unroll
                for (int m = 0; m < 4; ++m)
#pragma unroll
                    for (int n = 0; n < 2; ++n) acc[a][b][m][n] = (f32x4){0.f, 0.f, 0.f, 0.f};
        cur = nxt; cA = nA; cB = nB; ++ui;
        if constexpr (ALIGN_EPI) { if (wr == 1) PG8_BAR; }
    }
    PG8_WAIT_V(0);
    if constexpr (!ALIGN_EPI) { if (wr == 0) PG8_BAR; }
    PG8_BAR;
    if constexpr (Epi::AFTER_DRAIN) { E.fused(acc, cur, wr, wc, fr, fq, lds, wid, lane); S.done(cur); }
#undef PG8_SA
#undef PG8_SB
#undef PG8_STAGE
#undef PG8_LDA
#undef PG8_LDB
#undef PG8_MMA
#undef PG8_WAIT_V
#undef PG8_WAIT_L
#undef PG8_BAR
#undef PG8_SCHED
}
}
#define LAS __attribute__((address_space(3)))
typedef unsigned short bf16_t;
typedef short bf16x8 __attribute__((ext_vector_type(8)));
typedef short s16x4 __attribute__((ext_vector_type(4)));
typedef float f32x4 __attribute__((ext_vector_type(4)));
typedef unsigned u32x4 __attribute__((ext_vector_type(4)));
typedef unsigned u32x2 __attribute__((ext_vector_type(2)));

constexpr int SEQ = 8192, NBATCH = 4, MTOK = NBATCH * SEQ, DM = 1024, NWAVES = 8;
constexpr float LOG2E = 1.4426950408889634f, LN2F = 0.6931471805599453f, LN_EPS = 1e-5f, DN_ALPHA = 1.681792830507429f;
constexpr size_t MiB = 1u << 20;
constexpr size_t WS_ROPE = 0, WS_KMH = 512 * 1024, WS_KML = 768 * 1024, WS_LSE = 1 * MiB;
constexpr size_t WS_WIN0 = 10 * MiB, WS_WIN1 = 18 * MiB, WS_WIN2 = 26 * MiB, WS_WIN3 = 31 * MiB, WS_WOUT = 51 * MiB;
constexpr size_t WS_XN = 59 * MiB, WS_YG = 123 * MiB, WS_QKV = 187 * MiB, WS_END = 507 * MiB;
constexpr int LDS_BYTES = 147456, RING_BYTES = 131072, MISC_OFF = RING_BYTES + 320;
constexpr size_t WS_BAR = 9 * MiB, BAR_BYTES = 16384;

__device__ __forceinline__ unsigned f2bf(float f) { unsigned u = __builtin_bit_cast(unsigned, f); return (u + 0x7fffu + ((u >> 16) & 1u)) >> 16; }
__device__ __forceinline__ unsigned pk2(float lo, float hi) { return pg8::cvt_pk_bf16(lo, hi); }
__device__ __forceinline__ float bf2f(unsigned short b) { return __builtin_bit_cast(float, (unsigned)b << 16); }
__device__ __forceinline__ float bflo(unsigned w) { return __builtin_bit_cast(float, w << 16); }
__device__ __forceinline__ float bfhi(unsigned w) { return __builtin_bit_cast(float, w & 0xffff0000u); }
__device__ __forceinline__ float wave_sum(float v) {
#pragma unroll
    for (int o = 1; o < 64; o <<= 1) v += __shfl_xor(v, o);
    return v;
}
__device__ __forceinline__ float fexp2(float x) { return __builtin_amdgcn_exp2f(x); }
__device__ __forceinline__ float flog2(float x) { return __builtin_amdgcn_logf(x); }

__device__ __forceinline__ void transpose_item(const float* W, int K, int N, bf16_t* WT, LAS float* scr, int item, int lane) {
    const int nblk = N / 32, kb = item / nblk, nb = item % nblk, k0 = 64 * kb, n0 = 32 * nb;
    float wv[32];
#pragma unroll
    for (int i = 0; i < 32; ++i) wv[i] = W[(size_t)(k0 + 2 * i + (lane >> 5)) * N + n0 + (lane & 31)];
#pragma unroll
    for (int i = 0; i < 32; ++i) scr[(2 * i + (lane >> 5)) * 33 + (lane & 31)] = wv[i];
    asm volatile("s_waitcnt lgkmcnt(0)" ::: "memory");
    const int c = lane & 7;
#pragma unroll
    for (int j = 0; j < 4; ++j) { const int n = (lane >> 3) + 8 * j; const LAS float* s = scr + (8 * c) * 33 + n;
        u32x4 o; o.x = pk2(s[0 * 33], s[1 * 33]); o.y = pk2(s[2 * 33], s[3 * 33]); o.z = pk2(s[4 * 33], s[5 * 33]); o.w = pk2(s[6 * 33], s[7 * 33]);
        *(u32x4*)(WT + (size_t)(n0 + n) * K + k0 + 8 * c) = o; }
    asm volatile("s_waitcnt lgkmcnt(0)" ::: "memory");
}

constexpr int NQ = 2, QW = 16 * NQ, VROW = 144;
#define MFMA16(a, b, c) __builtin_amdgcn_mfma_f32_16x16x32_bf16((a), (b), (c), 0, 0, 0)
__device__ __forceinline__ bf16x8 ldg8(const bf16_t* p) { return *(const bf16x8*)p; }
__device__ __forceinline__ s16x4 vtr(const LAS char* p) { return __builtin_bit_cast(s16x4, __builtin_amdgcn_ds_read_tr16_b64_v4i16((LAS s16x4*)p)); }

__device__ __forceinline__ void load_kfrag(bf16x8 (&kf)[2][2], const bf16_t* Kh, int ld, int tok0, int tok1, int g) {
    const bf16_t* p0 = Kh + (size_t)tok0 * ld + 8 * g; const bf16_t* p1 = Kh + (size_t)tok1 * ld + 8 * g;
    kf[0][0] = ldg8(p0); kf[0][1] = ldg8(p0 + 32); kf[1][0] = ldg8(p1); kf[1][1] = ldg8(p1 + 32);
}
__device__ __forceinline__ void load_vraw(u32x4 (&vr)[4], const bf16_t* Vh, int ld, const int (&vtok)[4], int lane) {
#pragma unroll
    for (int i = 0; i < 4; ++i) vr[i] = *(const u32x4*)(Vh + (size_t)vtok[i] * ld + 8 * (lane & 7));
}
__device__ __forceinline__ void stage_v(LAS char* vst, const u32x4 (&vr)[4], int lane) {
    asm volatile("" ::: "memory");
#pragma unroll
    for (int i = 0; i < 4; ++i) *(LAS u32x4*)(vst + ((lane >> 3) + 8 * i) * VROW + (lane & 7) * 16) = vr[i];
    asm volatile("" ::: "memory");
}
__device__ __forceinline__ void read_vfrag(bf16x8 (&vf)[4], const LAS char* vst, int lane) {
    const int g = lane >> 4, i16 = lane & 15, q = i16 >> 2, p = i16 & 3;
    const LAS char* base = vst + (4 * g + q) * VROW + 8 * p;
#pragma unroll
    for (int dt = 0; dt < 4; ++dt) { const s16x4 lo = vtr(base + 32 * dt), hi = vtr(base + 16 * VROW + 32 * dt);
        vf[dt] = (bf16x8){lo[0], lo[1], lo[2], lo[3], hi[0], hi[1], hi[2], hi[3]}; }
    asm volatile("" ::: "memory");
}
__device__ __forceinline__ void qk_tiles(f32x4& s0, f32x4& s1, const bf16x8 (&kf)[2][2], const bf16x8 (&qf)[2]) {
    const f32x4 z = {0.f, 0.f, 0.f, 0.f};
    s0 = MFMA16(kf[0][0], qf[0], z); s0 = MFMA16(kf[0][1], qf[1], s0);
    s1 = MFMA16(kf[1][0], qf[0], z); s1 = MFMA16(kf[1][1], qf[1], s1);
}
__device__ __forceinline__ bf16x8 pack_p(const f32x4& p0, const f32x4& p1) {
    u32x4 w; w.x = pk2(p0[0], p0[1]); w.y = pk2(p0[2], p0[3]); w.z = pk2(p1[0], p1[1]); w.w = pk2(p1[2], p1[3]);
    return __builtin_bit_cast(bf16x8, w);
}
__device__ __forceinline__ void softmax_pv(f32x4 s0, f32x4 s1, float& m, float& l, f32x4 (&o)[4], const bf16x8 (&vf)[4]) {
    float mx = fmaxf(fmaxf(fmaxf(s0[0], s0[1]), fmaxf(s0[2], s0[3])), fmaxf(fmaxf(s1[0], s1[1]), fmaxf(s1[2], s1[3])));
    mx = fmaxf(mx, __shfl_xor(mx, 16)); mx = fmaxf(mx, __shfl_xor(mx, 32));
    const float mn = fmaxf(m, mx), al = fexp2(m - mn); m = mn;
    f32x4 p0, p1;
#pragma unroll
    for (int e = 0; e < 4; ++e) { p0[e] = fexp2(s0[e] - mn); p1[e] = fexp2(s1[e] - mn); }
    l = l * al + ((p0[0] + p0[1]) + (p0[2] + p0[3])) + ((p1[0] + p1[1]) + (p1[2] + p1[3]));
    const bf16x8 pf = pack_p(p0, p1);
#pragma unroll
    for (int dt = 0; dt < 4; ++dt) { o[dt] = o[dt] * al; o[dt] = MFMA16(vf[dt], pf, o[dt]); }
}
__device__ __forceinline__ void store_gated(const f32x4 (&o)[4], float inv, const bf16_t* zrow, bf16_t* yrow, int g) {
#pragma unroll
    for (int dt = 0; dt < 4; ++dt) { const u32x2 zz = *(const u32x2*)(zrow + 16 * dt + 4 * g);
        u32x2 w; w.x = pk2(o[dt][0] * inv * bflo(zz.x), o[dt][1] * inv * bfhi(zz.x)); w.y = pk2(o[dt][2] * inv * bflo(zz.y), o[dt][3] * inv * bfhi(zz.y));
        *(u32x2*)(yrow + 16 * dt + 4 * g) = w; }
}

__device__ __forceinline__ void sb_unit(const bf16_t* QKV, bf16_t* YG, int b, int h, int t0, LAS char* vst, int lane) {
    constexpr int ld = 4096;
    const int g = lane >> 4, ql = lane & 15;
    const bf16_t* Qh = QKV + h * 64; const bf16_t* Kh = QKV + 1024 + h * 64; const bf16_t* Vh = QKV + 2048 + h * 64; const bf16_t* Zh = QKV + 3072 + h * 64;
    const int rb = b * SEQ;
    bf16x8 qf[NQ][2]; f32x4 o[NQ][4]; float carry[NQ];
#pragma unroll
    for (int nq = 0; nq < NQ; ++nq) { const bf16_t* qp = Qh + (size_t)(rb + t0 + 16 * nq + ql) * ld + 8 * g; qf[nq][0] = ldg8(qp); qf[nq][1] = ldg8(qp + 32); carry[nq] = 0.f;
#pragma unroll
        for (int dt = 0; dt < 4; ++dt) o[nq][dt] = (f32x4){0.f, 0.f, 0.f, 0.f}; }
    bf16x8 kfn[2][2]; u32x4 vrn[4];
    { const int kb = t0 + QW - 32; int vt[4];
#pragma unroll
      for (int i = 0; i < 4; ++i) vt[i] = rb + kb + (lane >> 3) + 8 * i;
      load_kfrag(kfn, Kh, ld, rb + kb + ql, rb + kb + 16 + ql, g); load_vraw(vrn, Vh, ld, vt, lane); }
    for (int kb = t0 + QW - 32; kb >= 0; kb -= 32) {
        bf16x8 kf[2][2]; bf16x8 vf[4];
#pragma unroll
        for (int a = 0; a < 2; ++a)
#pragma unroll
            for (int c = 0; c < 2; ++c) kf[a][c] = kfn[a][c];
        stage_v(vst, vrn, lane);
        { const int kn = kb >= 32 ? kb - 32 : 0; int vt[4];
#pragma unroll
            for (int i = 0; i < 4; ++i) vt[i] = rb + kn + (lane >> 3) + 8 * i;
            load_kfrag(kfn, Kh, ld, rb + kn + ql, rb + kn + 16 + ql, g); load_vraw(vrn, Vh, ld, vt, lane); }
        read_vfrag(vf, vst, lane);
        bool alldone = true;
#pragma unroll
        for (int nq = 0; nq < NQ; ++nq) {
            const int t = t0 + 16 * nq + ql;
            if (kb >= t0 + 16 * nq + 16) continue;
            if (__all(carry[nq] < -110.f)) continue;
            f32x4 z[2]; qk_tiles(z[0], z[1], kf, qf[nq]);
            f32x4 L[2], lb[2]; bool valid[2][4];
#pragma unroll
            for (int T = 0; T < 2; ++T)
#pragma unroll
                for (int e = 0; e < 4; ++e) { const float zz = z[T][e]; const int key = kb + 16 * T + 4 * g + e; valid[T][e] = key < t;
                    const float sp = fmaxf(zz, 0.f) + LN2F * flog2(1.f + fexp2(-LOG2E * fabsf(zz)));
                    L[T][e] = valid[T][e] ? -sp : 0.f; lb[T][e] = zz - sp; }
            float ex[2][4], G[2], TT[2];
#pragma unroll
            for (int T = 0; T < 2; ++T) { ex[T][3] = 0.f; ex[T][2] = L[T][3]; ex[T][1] = L[T][3] + L[T][2]; ex[T][0] = ex[T][1] + L[T][1]; const float tot = ex[T][0] + L[T][0];
                const float a1 = __shfl_down(tot, 16), a2 = __shfl_down(tot, 32), a3 = __shfl_down(tot, 48);
                G[T] = (g < 3 ? a1 : 0.f) + (g < 2 ? a2 : 0.f) + (g < 1 ? a3 : 0.f);
                TT[T] = __shfl(G[T] + tot, ql); }
            f32x4 p[2];
#pragma unroll
            for (int e = 0; e < 4; ++e) { const float b1 = carry[nq] + G[1] + ex[1][e], b0 = carry[nq] + TT[1] + G[0] + ex[0][e];
                p[1][e] = valid[1][e] ? fexp2(LOG2E * (lb[1][e] + b1)) : 0.f; p[0][e] = valid[0][e] ? fexp2(LOG2E * (lb[0][e] + b0)) : 0.f; }
            carry[nq] += TT[1] + TT[0];
            const bf16x8 pf = pack_p(p[0], p[1]);
#pragma unroll
            for (int dt = 0; dt < 4; ++dt) o[nq][dt] = MFMA16(vf[dt], pf, o[nq][dt]);
        }
#pragma unroll
        for (int nq = 0; nq < NQ; ++nq) alldone = alldone && (carry[nq] < -110.f);
        if (__all(alldone)) break;
    }
#pragma unroll
    for (int nq = 0; nq < NQ; ++nq) { const size_t row = (size_t)(rb + t0 + 16 * nq + ql); store_gated(o[nq], 1.f, Zh + row * ld, YG + row * DM + h * 64, g); }
}

#define LDS_BARRIER() asm volatile("s_waitcnt lgkmcnt(0)\n\ts_barrier" ::: "memory")
constexpr int BL_KIMG = 0, BL_VIMG = 384 * VROW;
template <int MODE>
__device__ __forceinline__ void band_lds_phase(bf16_t* QKV, bf16_t* YG, float* LSE, const float* sinks, LAS unsigned char* lds, int G, int tid) {
    const int lane = tid & 63, wave = __builtin_amdgcn_readfirstlane(tid >> 6), g = lane >> 4, ql = lane & 15;
    LAS char* Kimg = (LAS char*)lds + BL_KIMG; LAS char* Vimg = (LAS char*)lds + BL_VIMG;
    constexpr int NUNITS = MODE == 0 ? NBATCH * 4 * (SEQ / 64) : 3 * 1024;
    constexpr int ld = MODE == 0 ? 2560 : 64, QSPAN = MODE == 0 ? 64 : 256, max_back = MODE == 0 ? 127 : 128;
    u32x4 pre[12]; bf16x8 qn[2][2];
#define BL_DECODE(U_) \
    int d_dil, d_i0, d_rowbase, d_h0, d_bl = 0; const bf16_t* d_K; \
    if (MODE == 0) { const int kvh_ = (U_) & 3, chunk = ((U_) >> 2) & 127, b_ = (U_) >> 9; d_dil = 1; d_i0 = chunk * 64; d_rowbase = b_ * SEQ; d_h0 = kvh_ * 4; d_K = QKV + 1024 + kvh_ * 64; }     \
    else { const int grp = (U_) >> 10, v = (U_) & 1023; d_dil = grp == 0 ? 1 : (grp == 1 ? 4 : 16); const int nch = (SEQ / 256) / d_dil; d_h0 = v & 15; const int rest = v >> 4; const int chunk = rest % nch, s = rest / nch; \
        d_bl = s / d_dil; d_rowbase = s % d_dil; d_i0 = chunk * 256; d_K = QKV + (size_t)((((3 * grp + 1) * 2 + d_bl) * 16 + d_h0) * SEQ) * 64; } \
    const int d_kw0 = d_i0 >= 128 ? d_i0 - 128 : 0, d_nrows = d_i0 + QSPAN - d_kw0; const bf16_t* d_V = d_K + (MODE == 0 ? 256 : 2 * 16 * SEQ * 64);
#define BL_LOAD(U_) do { BL_DECODE(U_) \
        const unsigned voff = (unsigned)(((tid >> 3) * d_dil * ld + 8 * (tid & 7)) * 2); const size_t cstride = (size_t)64 * d_dil * ld * 2; \
        const char* kbp = (const char*)(d_K + (size_t)(d_rowbase + d_kw0 * d_dil) * ld); const char* vbp = (const char*)(d_V + (size_t)(d_rowbase + d_kw0 * d_dil) * ld); \
        _Pragma("unroll") for (int c = 0; c < 6; ++c) { { const int cc_ = __builtin_amdgcn_readfirstlane(64 * c < d_nrows ? c : 0);     \
            const char* kc_ = kbp + cc_ * cstride; const char* vc_ = vbp + cc_ * cstride; asm volatile("" : "+s"(kc_), "+s"(vc_));     \
            pre[c] = *(const u32x4*)(kc_ + voff); pre[6 + c] = *(const u32x4*)(vc_ + voff); } } \
        { const int h_ = MODE == 0 ? d_h0 + (wave & 3) : d_h0, q0_ = MODE == 0 ? d_i0 + 32 * (wave >> 2) : d_i0 + 32 * wave; const bf16_t* Qh_ = MODE == 0 ? QKV + h_ * 64 : d_K - 2 * 16 * SEQ * 64; \
          _Pragma("unroll") for (int nq = 0; nq < 2; ++nq) { const bf16_t* qp = Qh_ + (size_t)(d_rowbase + (q0_ + 16 * nq + ql) * d_dil) * ld + 8 * g; qn[nq][0] = ldg8(qp); qn[nq][1] = ldg8(qp + 32); } } } while (0)
    int U = (int)blockIdx.x;
    if (U < NUNITS) BL_LOAD(U);
    for (; U < NUNITS; U += G) {
        BL_DECODE(U)
        LDS_BARRIER();
        { LAS char* kw = Kimg + (tid >> 3) * VROW + (tid & 7) * 16; LAS char* vw = Vimg + (tid >> 3) * VROW + (tid & 7) * 16;
#pragma unroll
          for (int c = 0; c < 6; ++c) { *(LAS u32x4*)(kw + c * 64 * VROW) = pre[c]; *(LAS u32x4*)(vw + c * 64 * VROW) = pre[6 + c]; } }
        LDS_BARRIER();
        bf16x8 qf[2][2];
#pragma unroll
        for (int nq = 0; nq < 2; ++nq) { qf[nq][0] = qn[nq][0]; qf[nq][1] = qn[nq][1]; }
        { const int Un = __builtin_amdgcn_readfirstlane(U + G < NUNITS ? U + G : U); BL_LOAD(Un); }
        const int h = MODE == 0 ? d_h0 + (wave & 3) : d_h0, q0 = MODE == 0 ? d_i0 + 32 * (wave >> 2) : d_i0 + 32 * wave;
        const bf16_t* Qh = MODE == 0 ? QKV + h * 64 : d_K - 2 * 16 * SEQ * 64;
        f32x4 o[2][4]; float m[2], l[2];
        const float sink2 = MODE == 0 ? sinks[h] * LOG2E : 0.f;
#pragma unroll
        for (int nq = 0; nq < 2; ++nq) {
            m[nq] = MODE == 0 ? sink2 : -1e30f; l[nq] = (MODE == 0 && g == 0) ? 1.f : 0.f;
#pragma unroll
            for (int dt = 0; dt < 4; ++dt) o[nq][dt] = (f32x4){0.f, 0.f, 0.f, 0.f}; }
        const int kstart = q0 >= 128 ? q0 - 128 : 0;
        const int i16q = ql >> 2, i16p = ql & 3;
        for (int kb = kstart; kb < q0 + 32; kb += 32) {
            const int kr = kb - d_kw0;
            bf16x8 kf[2][2], vf[4];
#pragma unroll
            for (int T = 0; T < 2; ++T) { const LAS char* kp = Kimg + (kr + 16 * T + ql) * VROW + 16 * g; kf[T][0] = *(const LAS bf16x8*)kp; kf[T][1] = *(const LAS bf16x8*)(kp + 64); }
            { const LAS char* vb = Vimg + (kr + 4 * g + i16q) * VROW + 8 * i16p;
#pragma unroll
              for (int dt = 0; dt < 4; ++dt) { const s16x4 lo = vtr(vb + 32 * dt), hi = vtr(vb + 16 * VROW + 32 * dt); vf[dt] = (bf16x8){lo[0], lo[1], lo[2], lo[3], hi[0], hi[1], hi[2], hi[3]}; } }
#pragma unroll
            for (int nq = 0; nq < 2; ++nq) {
                const int qlo = q0 + 16 * nq;
                if (kb > qlo + 15 || kb + 31 < qlo - max_back) continue;
                const int qi = qlo + ql;
                f32x4 s[2]; qk_tiles(s[0], s[1], kf, qf[nq]);
                if (!(kb + 31 <= qlo && qlo + 15 - kb <= max_back)) {
#pragma unroll
                    for (int T = 0; T < 2; ++T)
#pragma unroll
                        for (int e = 0; e < 4; ++e) { const int dist = qi - (kb + 16 * T + 4 * g + e); s[T][e] = (dist >= 0 && dist <= max_back) ? s[T][e] : -__builtin_inff(); }
                }
                softmax_pv(s[0], s[1], m[nq], l[nq], o[nq], vf);
            }
        }
#pragma unroll
        for (int nq = 0; nq < 2; ++nq) {
            float lt = l[nq]; lt += __shfl_xor(lt, 16); lt += __shfl_xor(lt, 32);
            const float inv = 1.f / lt; const int tok = d_rowbase + (q0 + 16 * nq + ql) * d_dil;
            if (MODE == 0) store_gated(o[nq], inv, QKV + (size_t)tok * ld + 1536 + h * 64, YG + (size_t)tok * DM + h * 64, g);
            else {
                bf16_t* op = (bf16_t*)Qh + (size_t)tok * ld;
#pragma unroll
                for (int dt = 0; dt < 4; ++dt) { u32x2 w; w.x = pk2(o[nq][dt][0] * inv, o[nq][dt][1] * inv); w.y = pk2(o[nq][dt][2] * inv, o[nq][dt][3] * inv); *(u32x2*)(op + 16 * dt + 4 * g) = w; }
                if (g == 0) LSE[(size_t)((U >> 10) * 16384 + d_bl * SEQ + tok) * 16 + h] = (m[nq] + flog2(lt)) * LN2F;
            }
        }
    }
    __syncthreads();
#undef BL_DECODE
#undef BL_LOAD
}

__device__ __forceinline__ void moba_own_unit(const bf16_t* QKV, const bf16_t* KMH, const bf16_t* KML, bf16_t* YG, float* LSE0, unsigned* SEL, int b, int h, int t0, LAS char* vst, int lane) {
    constexpr int ld = 4096;
    const int g = lane >> 4, ql = lane & 15;
    const bf16_t* Qh = QKV + h * 64; const bf16_t* Kh = QKV + 1024 + h * 64; const bf16_t* Vh = QKV + 2048 + h * 64;
    const int rb = b * SEQ, QB = t0 >> 8;
    bf16x8 qf[NQ][2]; f32x4 o[NQ][4]; float m[NQ], l[NQ];
#pragma unroll
    for (int nq = 0; nq < NQ; ++nq) { const bf16_t* qp = Qh + (size_t)(rb + t0 + 16 * nq + ql) * ld + 8 * g; qf[nq][0] = ldg8(qp); qf[nq][1] = ldg8(qp + 32); m[nq] = -1e30f; l[nq] = 0.f;
#pragma unroll
        for (int dt = 0; dt < 4; ++dt) o[nq][dt] = (f32x4){0.f, 0.f, 0.f, 0.f}; }
    {
        const bf16_t* kmh = KMH + (size_t)((b * 16 + h) * 32) * 64; const bf16_t* kml = KML + (size_t)((b * 16 + h) * 32) * 64;
        bf16x8 ah[2][2], al[2][2];
#pragma unroll
        for (int T = 0; T < 2; ++T)
#pragma unroll
            for (int ks = 0; ks < 2; ++ks) { ah[T][ks] = ldg8(kmh + (16 * T + ql) * 64 + 32 * ks + 8 * g); al[T][ks] = ldg8(kml + (16 * T + ql) * 64 + 32 * ks + 8 * g); }
#pragma unroll
        for (int nq = 0; nq < NQ; ++nq) {
            f32x4 gt[2];
#pragma unroll
            for (int T = 0; T < 2; ++T) { f32x4 a = {0.f, 0.f, 0.f, 0.f}; a = MFMA16(al[T][0], qf[nq][0], a); a = MFMA16(al[T][1], qf[nq][1], a); a = MFMA16(ah[T][0], qf[nq][0], a); a = MFMA16(ah[T][1], qf[nq][1], a); gt[T] = a; }
            float gv[8];
#pragma unroll
            for (int T = 0; T < 2; ++T)
#pragma unroll
                for (int e = 0; e < 4; ++e) gv[4 * T + e] = (16 * T + 4 * g + e) < QB ? gt[T][e] : -__builtin_inff();
            unsigned s = 0u;
#pragma unroll
            for (int r = 0; r < 3; ++r) {
                float bv = -__builtin_inff(); int bi = 64;
#pragma unroll
                for (int c = 0; c < 8; ++c) { const int idx = 16 * (c >> 2) + 4 * g + (c & 3); if (gv[c] > bv) { bv = gv[c]; bi = idx; } }
#pragma unroll
                for (int off = 16; off < 64; off <<= 1) { const float ov = __shfl_xor(bv, off); const int oi = __shfl_xor(bi, off); if (ov > bv || (ov == bv && oi < bi)) { bv = ov; bi = oi; } }
                if (bi < 32) { s |= 1u << bi;
#pragma unroll
                    for (int c = 0; c < 8; ++c) { const int idx = 16 * (c >> 2) + 4 * g + (c & 3); if (idx == bi) gv[c] = -__builtin_inff(); } }
            }
            if (g == 0) SEL[(size_t)(b * 16 + h) * SEQ + t0 + 16 * nq + ql] = s;
        }
    }
    const int kend = t0 + QW;
    bf16x8 kfn[2][2]; u32x4 vrn[4];
#define MOBA_PREFETCH(kb_) do { const int kb__ = rb + (kb_); int vt[4]; \
        _Pragma("unroll") for (int i = 0; i < 4; ++i) vt[i] = kb__ + (lane >> 3) + 8 * i; \
        load_kfrag(kfn, Kh, ld, kb__ + ql, kb__ + 16 + ql, g); load_vraw(vrn, Vh, ld, vt, lane); } while (0)
    MOBA_PREFETCH(QB * 256);
    for (int kb = QB * 256; kb < kend; kb += 32) {
        bf16x8 kf[2][2]; bf16x8 vf[4];
#pragma unroll
        for (int a = 0; a < 2; ++a)
#pragma unroll
            for (int c = 0; c < 2; ++c) kf[a][c] = kfn[a][c];
        stage_v(vst, vrn, lane);
        MOBA_PREFETCH(kb + 32 < kend ? kb + 32 : kb);
        read_vfrag(vf, vst, lane);
#pragma unroll
        for (int nq = 0; nq < NQ; ++nq) {
            if (kb > t0 + 16 * nq + 15) continue;
            const int t = t0 + 16 * nq + ql;
            f32x4 s[2]; qk_tiles(s[0], s[1], kf, qf[nq]);
            if (kb + 31 > t0 + 16 * nq) {
#pragma unroll
                for (int T = 0; T < 2; ++T)
#pragma unroll
                    for (int e = 0; e < 4; ++e) { const int key = kb + 16 * T + 4 * g + e; s[T][e] = (key <= t) ? s[T][e] : -__builtin_inff(); }
            }
            softmax_pv(s[0], s[1], m[nq], l[nq], o[nq], vf);
        }
    }
#undef MOBA_PREFETCH
#pragma unroll
    for (int nq = 0; nq < NQ; ++nq) { float lt = l[nq]; lt += __shfl_xor(lt, 16); lt += __shfl_xor(lt, 32);
        const float inv = 1.f / lt; const size_t row = (size_t)(rb + t0 + 16 * nq + ql); bf16_t* op = YG + row * DM + h * 64;
#pragma unroll
        for (int dt = 0; dt < 4; ++dt) { u32x2 w; w.x = pk2(o[nq][dt][0] * inv, o[nq][dt][1] * inv); w.y = pk2(o[nq][dt][2] * inv, o[nq][dt][3] * inv); *(u32x2*)(op + 16 * dt + 4 * g) = w; }
        if (g == 0) LSE0[row * 16 + h] = (m[nq] + flog2(lt)) * LN2F; }
}

constexpr int MR_KIMG = 0, MR_VIMG = 36864, MR_LIST = 73728, MR_CNT = 73728 + 32768;
__device__ __forceinline__ void moba_routed_unit(const bf16_t* QKV, const unsigned* SEL, bf16_t* YG, float* LSE0, bf16_t* PA, float* LSEA, bf16_t* PB, float* LSEB,
                                                 int b, int h, int j, LAS unsigned char* lds, int tid) {
    constexpr int ld = 4096;
    const int lane = tid & 63, wave = __builtin_amdgcn_readfirstlane(tid >> 6), g = lane >> 4, ql = lane & 15;
    LAS char* Kimg = (LAS char*)lds + MR_KIMG; LAS char* Vimg = (LAS char*)lds + MR_VIMG; LAS unsigned* list = (LAS unsigned*)(lds + MR_LIST); LAS unsigned* cnt = (LAS unsigned*)(lds + MR_CNT);
    LDS_BARRIER();
    if (tid == 0) *cnt = 0u;
    const int rb = b * SEQ + j * 256;
#pragma unroll
    for (int i = 0; i < 4; ++i) { const int chunk = tid + 512 * i, row = chunk >> 3, c = chunk & 7; const bf16_t* src = QKV + (size_t)(rb + row) * ld + h * 64 + 8 * c;
        *(LAS u32x4*)(Kimg + row * VROW + c * 16) = *(const u32x4*)(src + 1024); *(LAS u32x4*)(Vimg + row * VROW + c * 16) = *(const u32x4*)(src + 2048); }
    LDS_BARRIER();
    const unsigned* selp = SEL + (size_t)(b * 16 + h) * SEQ;
    {
        unsigned mks[16];
#pragma unroll
        for (int i = 0; i < 16; ++i) { const int tb = (j + 1) * 256 + wave * 64 + 512 * i; mks[i] = tb < SEQ ? selp[tb + lane] : 0u; }
#pragma unroll
        for (int i = 0; i < 16; ++i) { const int tb = (j + 1) * 256 + wave * 64 + 512 * i; if (tb >= SEQ) break;
            const unsigned mk = mks[i]; const bool hit = (mk >> j) & 1u;
            const unsigned long long bal = __ballot(hit); const unsigned nh = (unsigned)__popcll(bal);
            unsigned base = 0u; if (lane == 0 && nh) base = __hip_atomic_fetch_add(cnt, nh, __ATOMIC_RELAXED, __HIP_MEMORY_SCOPE_WORKGROUP);
            base = (unsigned)__builtin_amdgcn_readfirstlane((int)base);
            if (hit) { const unsigned rank = __builtin_popcount(mk & ((1u << j) - 1u)); const unsigned pos = base + (unsigned)__popcll(bal & ((1ull << lane) - 1ull)); list[pos] = (unsigned)(tb + lane) | (rank << 16); } }
    }
    LDS_BARRIER();
    const int n = (int)*cnt, ntiles = (n + 15) >> 4;
    unsigned e_n = 0u; bool valid_n = false; bf16x8 q0n = {0, 0, 0, 0, 0, 0, 0, 0}, q1n = q0n; u32x2 ovn[4]; float oldn = 0.f;
#pragma unroll
    for (int dt = 0; dt < 4; ++dt) ovn[dt] = (u32x2){0u, 0u};
#define MR_FETCH(tile_) do { const int idx_ = 16 * (tile_) + ql; valid_n = idx_ < n; e_n = list[valid_n ? idx_ : n - 1]; const size_t row_ = (size_t)(b * SEQ + (int)(e_n & 0xffffu)); \
        const bf16_t* qp_ = QKV + row_ * ld + h * 64 + 8 * g; q0n = ldg8(qp_); q1n = ldg8(qp_ + 32); \
        { oldn = LSE0[row_ * 16 + h]; const bf16_t* op_ = YG + row_ * DM + h * 64 + 4 * g;     \
            _Pragma("unroll") for (int dt = 0; dt < 4; ++dt) ovn[dt] = *(const u32x2*)(op_ + 16 * dt); } } while (0)
    if (wave < ntiles) MR_FETCH(wave);
    for (int tile = wave; tile < ntiles; tile += NWAVES) {
        const bool valid = valid_n; const unsigned e = e_n; const int t = (int)(e & 0xffffu), rank = (int)(e >> 16);
        const size_t row = (size_t)(b * SEQ + t);
        const bf16x8 q0 = q0n, q1 = q1n; const float old = oldn; u32x2 ov[4];
#pragma unroll
        for (int dt = 0; dt < 4; ++dt) ov[dt] = ovn[dt];
        { const int tn = tile + NWAVES < ntiles ? tile + NWAVES : tile; MR_FETCH(tn); }
        f32x4 s[16]; float mx = -1e30f;
#pragma unroll
        for (int T = 0; T < 16; ++T) { const LAS char* kp = Kimg + (16 * T + ql) * VROW + 16 * g; const bf16x8 a0 = *(const LAS bf16x8*)kp, a1 = *(const LAS bf16x8*)(kp + 64);
            f32x4 a = {0.f, 0.f, 0.f, 0.f}; a = MFMA16(a0, q0, a); a = MFMA16(a1, q1, a); s[T] = a; mx = fmaxf(mx, fmaxf(fmaxf(s[T][0], s[T][1]), fmaxf(s[T][2], s[T][3]))); }
        mx = fmaxf(mx, __shfl_xor(mx, 16)); mx = fmaxf(mx, __shfl_xor(mx, 32));
        float l = 0.f; f32x4 o[4];
#pragma unroll
        for (int dt = 0; dt < 4; ++dt) o[dt] = (f32x4){0.f, 0.f, 0.f, 0.f};
        const int i16q = ql >> 2, i16p = ql & 3;
#pragma unroll
        for (int k8 = 0; k8 < 8; ++k8) { f32x4 p0, p1;
#pragma unroll
            for (int c = 0; c < 4; ++c) { p0[c] = fexp2(s[2 * k8][c] - mx); p1[c] = fexp2(s[2 * k8 + 1][c] - mx); }
            l += ((p0[0] + p0[1]) + (p0[2] + p0[3])) + ((p1[0] + p1[1]) + (p1[2] + p1[3]));
            const bf16x8 pf = pack_p(p0, p1);
            const LAS char* vb = Vimg + (32 * k8 + 4 * g + i16q) * VROW + 8 * i16p;
#pragma unroll
            for (int dt = 0; dt < 4; ++dt) { const s16x4 lo = vtr(vb + 32 * dt), hi = vtr(vb + 16 * VROW + 32 * dt);
                const bf16x8 vf = (bf16x8){lo[0], lo[1], lo[2], lo[3], hi[0], hi[1], hi[2], hi[3]}; o[dt] = MFMA16(vf, pf, o[dt]); } }
        l += __shfl_xor(l, 16); l += __shfl_xor(l, 32);
        const float inv = 1.f / l, lse = (mx + flog2(l)) * LN2F;
        if (valid) {
            if (rank == 0) {
                const float mm = fmaxf(old, lse); const float wo = fexp2((old - mm) * LOG2E), wn = fexp2((lse - mm) * LOG2E); const float i2 = 1.f / (wo + wn);
                const float co = wo * i2, cn = wn * i2 * inv; bf16_t* op = YG + row * DM + h * 64;
#pragma unroll
                for (int dt = 0; dt < 4; ++dt) {
                    u32x2 w; w.x = pk2(co * bflo(ov[dt].x) + cn * o[dt][0], co * bfhi(ov[dt].x) + cn * o[dt][1]); w.y = pk2(co * bflo(ov[dt].y) + cn * o[dt][2], co * bfhi(ov[dt].y) + cn * o[dt][3]); *(u32x2*)(op + 16 * dt + 4 * g) = w; }
                if (g == 0) LSE0[row * 16 + h] = mm + flog2(wo + wn) * LN2F;
            } else {
                bf16_t* op = (rank == 1 ? PA : PB) + row * DM + h * 64; float* lp = (rank == 1 ? LSEA : LSEB);
#pragma unroll
                for (int dt = 0; dt < 4; ++dt) { u32x2 w; w.x = pk2(o[dt][0] * inv, o[dt][1] * inv); w.y = pk2(o[dt][2] * inv, o[dt][3] * inv); *(u32x2*)(op + 16 * dt + 4 * g) = w; }
                if (g == 0) lp[row * 16 + h] = lse;
            }
        }
    }
#undef MR_FETCH
}

#define XB_TMO      128
#define XB_XCNT(j)  (256  + 64 * (j))
#define XB_XSUB(j)  (1280 + 64 * (j))
#define XB_XGEN(j)  (2304 + 64 * (j))
#define XB_TOP      3328
#define XB_TOPGEN   3392
#define XCD_BAR_WORDS 3456
#define XB_SPIN_CAP (1u << 18)

__device__ __forceinline__ unsigned xb_ld(unsigned* p)              { return __hip_atomic_load(p, __ATOMIC_RELAXED, __HIP_MEMORY_SCOPE_AGENT); }
__device__ __forceinline__ unsigned xb_add(unsigned* p, unsigned v) { return __hip_atomic_fetch_add(p, v, __ATOMIC_RELAXED, __HIP_MEMORY_SCOPE_AGENT); }
__device__ __forceinline__ unsigned xb_xcc_id() { return (unsigned)__builtin_amdgcn_s_getreg((3 << 11) | 20) & 0xFu; }
#define XB_SPIN(cond, bar) do { unsigned _sp = 0; while (cond) { __builtin_amdgcn_s_sleep(1); \
    if ((++_sp & 255u) == 0u) { if (xb_ld(&(bar)[XB_TMO])) break; if (_sp > XB_SPIN_CAP) { atomicAdd(&(bar)[XB_TMO], 1u); break; } } } } while (0)

struct XcdBarrier {
    unsigned* bar; unsigned x;
    volatile LAS unsigned* st;
};

__device__ __forceinline__ XcdBarrier xcd_barrier_post(unsigned* bar, volatile LAS unsigned* st) {
    XcdBarrier b; b.bar = bar; b.x = xb_xcc_id(); b.st = st;
    if (threadIdx.x == 0) (void)xb_add(&bar[XB_XCNT(b.x)], 1u);
    return b;
}
__device__ __forceinline__ void xcd_barrier_complete(unsigned* bar, unsigned x, unsigned& nloc, unsigned& nx) {
    const unsigned G = gridDim.x * gridDim.y * gridDim.z;
    unsigned sum, cnt, mine, sp = 0u;
    for (;;) {
        sum = 0u; cnt = 0u; mine = 0u;
#pragma unroll
        for (unsigned j = 0; j < 16; ++j) { const unsigned c = xb_ld(&bar[XB_XCNT(j)]); sum += c; cnt += (c > 0u) ? 1u : 0u; mine = (j == x) ? c : mine; }
        if (sum == G) break;
        __builtin_amdgcn_s_sleep(1);
        if ((++sp & 255u) == 0u) { if (xb_ld(&bar[XB_TMO])) break; if (sp > XB_SPIN_CAP) { atomicAdd(&bar[XB_TMO], 1u); break; } }
    }
    nloc = mine > 0u ? mine : 1u; nx = cnt > 0u ? cnt : 1u;
}

__device__ __forceinline__ void xcd_barrier(const XcdBarrier& b) {
    asm volatile("s_waitcnt vmcnt(0)" ::: "memory");
    __syncthreads();
    if (threadIdx.x == 0) {
        unsigned* bar = b.bar;
        __builtin_amdgcn_s_waitcnt(0);
        unsigned nloc = b.st[0], nx = b.st[1];
        if (nloc == 0u) { xcd_barrier_complete(bar, b.x, nloc, nx); b.st[0] = nloc; b.st[1] = nx; }
        const unsigned old = xb_add(&bar[XB_XSUB(b.x)], 1u);
        const unsigned gen = old / nloc;
        if (old + 1u == (gen + 1u) * nloc) {
            __builtin_amdgcn_fence(__ATOMIC_RELEASE, "agent");
            asm volatile("s_waitcnt vmcnt(0)" ::: "memory");
            const unsigned og = xb_add(&bar[XB_TOP], 1u);
            const unsigned tg = og / nx;
            if (og + 1u == (tg + 1u) * nx) xb_add(&bar[XB_TOPGEN], 1u);
            else XB_SPIN(xb_ld(&bar[XB_TOPGEN]) == tg, bar);
            __builtin_amdgcn_fence(__ATOMIC_ACQUIRE, "agent");
            xb_add(&bar[XB_XGEN(b.x)], 1u);
            asm volatile("s_waitcnt vmcnt(0)" ::: "memory");
        } else {
            XB_SPIN(xb_ld(&bar[XB_XGEN(b.x)]) == gen, bar);
            __builtin_amdgcn_fence(__ATOMIC_ACQUIRE, "agent");
            asm volatile("s_waitcnt vmcnt(0)" ::: "memory");
        }
    }
    __syncthreads();
}

struct Args { const float* in[18]; float* out; unsigned char* ws; int ph_lo, ph_hi; };
constexpr int N_PHASES = 24;

__global__ void __launch_bounds__(NWAVES * 64, 2) hybrid_fwd(Args args) {
    extern __shared__ __attribute__((aligned(16))) unsigned char lds[];
    cg::grid_group grid = cg::this_grid();
    LAS unsigned char* ldsl = (LAS unsigned char*)lds;
    const int tid = threadIdx.x, lane = tid & 63, wave = __builtin_amdgcn_readfirstlane(tid >> 6);
    const int G = gridDim.x, gw = blockIdx.x * NWAVES + wave, NGW = G * NWAVES;
    unsigned char* ws = args.ws;
    float* rope = (float*)(ws + WS_ROPE);
    bf16_t* KMH = (bf16_t*)(ws + WS_KMH); bf16_t* KML = (bf16_t*)(ws + WS_KML); float* LSE0 = (float*)(ws + WS_LSE); float* LSEA = (float*)(ws + WS_LSE + 2 * MiB); float* LSEB = (float*)(ws + WS_LSE + 4 * MiB); unsigned* SEL = (unsigned*)(ws + WS_LSE + 6 * MiB);
    bf16_t* WIN[4] = {(bf16_t*)(ws + WS_WIN0), (bf16_t*)(ws + WS_WIN1), (bf16_t*)(ws + WS_WIN2), (bf16_t*)(ws + WS_WIN3)};
    bf16_t* WOUT = (bf16_t*)(ws + WS_WOUT);
    bf16_t* XN = (bf16_t*)(ws + WS_XN); bf16_t* YG = (bf16_t*)(ws + WS_YG); bf16_t* QKV = (bf16_t*)(ws + WS_QKV); bf16_t* PA = (bf16_t*)(ws + WS_QKV + 256 * MiB); bf16_t* PB = XN;
    float* X = args.out;
    LAS char* vst = (LAS char*)(ldsl + wave * 16384);
    const int lo = args.ph_lo, hi = args.ph_hi;
#define IN(k) (lo <= (k) && (k) < hi)
    if (tid < 64) ((LAS unsigned*)(ldsl + MISC_OFF))[tid] = 0u;
    __syncthreads();
    (void)xcd_barrier_post((unsigned*)(ws + WS_BAR), (volatile LAS unsigned*)(ldsl + MISC_OFF) + 8);
    int ph = 0;
#define PH_IF if (IN(ph))
#define PH_END do { if (IN(ph) && IN(ph + 1)) { if (ph == 0) grid.sync(); else { XcdBarrier bar_; { unsigned* bp_ = (unsigned*)(args.ws + WS_BAR); asm volatile("" : "+s"(bp_)); bar_.bar = bp_; } bar_.x = xb_xcc_id(); bar_.st = (volatile LAS unsigned*)(ldsl + MISC_OFF) + 8; xcd_barrier(bar_); } } ++ph; } while (0)

    PH_IF {
        LAS float* scr = (LAS float*)(ldsl + wave * 16384);
        constexpr int C1 = 2048, C2 = 4096, C3 = 5376, C4 = 10496, C5 = 11008, C6 = 11520, C7 = 12032, C8 = 12544;
        for (int it = gw; it < C8; it += NGW) {
            const int mi = (it >= C1) + (it >= C2) + (it >= C3) + (it >= C4) + (it >= C5) + (it >= C6) + (it >= C7);
            const int base = mi == 0 ? 0 : mi == 1 ? C1 : mi == 2 ? C2 : mi == 3 ? C3 : mi == 4 ? C4 : mi == 5 ? C5 : mi == 6 ? C6 : C7;
            const int N = mi < 2 ? 4096 : mi == 2 ? 2560 : mi == 3 ? 10240 : 1024;
            const float* W = mi == 0 ? args.in[1] : mi == 1 ? args.in[5] : mi == 2 ? args.in[9] : mi == 3 ? args.in[14] : mi == 4 ? args.in[2] : mi == 5 ? args.in[6] : mi == 6 ? args.in[11] : args.in[15];
            const size_t woff = mi == 0 ? WS_WIN0 : mi == 1 ? WS_WIN1 : mi == 2 ? WS_WIN2 : mi == 3 ? WS_WIN3 : WS_WOUT + (size_t)(mi - 4) * 2 * MiB;
            transpose_item(W, 1024, N, (bf16_t*)(ws + woff), scr, it - base, lane);
        }
        const int gt = blockIdx.x * (NWAVES * 64) + tid, NGT = G * NWAVES * 64;
        for (int idx = gt; idx < SEQ * 8; idx += NGT) { const int pos = idx >> 3, i = idx & 7;
            const float inv = (float)pow(500000.0, -(double)i / 8.0); const float ang = (float)pos * inv;
            double sn, cs; sincos((double)ang, &sn, &cs); rope[pos * 16 + i] = (float)cs; rope[pos * 16 + 8 + i] = (float)sn; }
        const float* x = args.in[0];
        for (size_t idx = gt; idx < (size_t)MTOK * DM / 8; idx += (size_t)NGT * 4) {
            f32x4 a[4], c[4];
#pragma unroll
            for (int r = 0; r < 4; ++r) { if (idx + (size_t)r * NGT < (size_t)MTOK * DM / 8) { a[r] = *(const f32x4*)(x + (idx + (size_t)r * NGT) * 8); c[r] = *(const f32x4*)(x + (idx + (size_t)r * NGT) * 8 + 4); } }
#pragma unroll
            for (int r = 0; r < 4; ++r) if (idx + (size_t)r * NGT < (size_t)MTOK * DM / 8) { u32x4 w; w.x = pk2(a[r][0], a[r][1]); w.y = pk2(a[r][2], a[r][3]); w.z = pk2(c[r][0], c[r][1]); w.w = pk2(c[r][2], c[r][3]); *(u32x4*)(XN + (idx + (size_t)r * NGT) * 8) = w; } }
    }
    PH_END;

#define GEMM_IN(layer_, A_, Mrows_, N_) do { pg8::Gemm gg{(A_), WIN[layer_], (Mrows_), (N_), DM}; pg8::StaticOrder S; S.init((Mrows_), (N_), G, (int)blockIdx.x); \
        pg8::EpiIn E{QKV, (N_), (layer_), rope}; pg8::gemm_phase<pg8::EpiIn, pg8::StaticOrder, true, true>(ldsl, gg, S, E); } while (0)
#define GEMM_OUT(layer_, Xsrc_) do { pg8::Gemm gg{YG, WOUT + (size_t)(layer_) * 1024 * 1024, MTOK, DM, DM}; pg8::StaticOrder S; S.init(MTOK, DM, G, (int)blockIdx.x); \
        pg8::EpiOut E{(Xsrc_), X, DN_ALPHA}; pg8::gemm_phase<pg8::EpiOut, pg8::StaticOrder, true, true>(ldsl, gg, S, E); } while (0)
#define LN_PHASE(gidx_, bidx_, write_xn_) do { const float* gp = args.in[gidx_]; const float* bp = args.in[bidx_]; \
        f32x4 gv[4], bv[4]; _Pragma("unroll") for (int jj = 0; jj < 4; ++jj) { gv[jj] = *(const f32x4*)(gp + 4 * lane + 256 * jj); bv[jj] = *(const f32x4*)(bp + 4 * lane + 256 * jj); } \
        for (int r = gw; r < MTOK; r += NGW) { float* xr = X + (size_t)r * DM + 4 * lane; f32x4 v[4]; float s = 0.f; \
            _Pragma("unroll") for (int jj = 0; jj < 4; ++jj) { v[jj] = *(const f32x4*)(xr + 256 * jj); s += (v[jj][0] + v[jj][1]) + (v[jj][2] + v[jj][3]); } \
            const float mean = wave_sum(s) * (1.f / DM); float s2 = 0.f; \
            _Pragma("unroll") for (int jj = 0; jj < 4; ++jj) { v[jj] = v[jj] - mean; s2 += (v[jj][0] * v[jj][0] + v[jj][1] * v[jj][1]) + (v[jj][2] * v[jj][2] + v[jj][3] * v[jj][3]); } \
            const float rstd = 1.f / sqrtf(wave_sum(s2) * (1.f / DM) + LN_EPS); \
            _Pragma("unroll") for (int jj = 0; jj < 4; ++jj) { v[jj] = v[jj] * rstd * gv[jj] + bv[jj]; *(f32x4*)(xr + 256 * jj) = v[jj]; \
                if (write_xn_) { u32x2 w; w.x = pk2(v[jj][0], v[jj][1]); w.y = pk2(v[jj][2], v[jj][3]); *(u32x2*)(XN + (size_t)r * DM + 4 * lane + 256 * jj) = w; } } } } while (0)

    PH_IF GEMM_IN(0, XN, MTOK, 4096);
    PH_END;
    PH_IF { for (int u = gw; u < NBATCH * 16 * (SEQ / QW); u += NGW) { const int bh = u & 63, q64 = u >> 6; sb_unit(QKV, YG, bh >> 4, bh & 15, q64 * QW, vst, lane); } }
    PH_END;
    PH_IF GEMM_OUT(0, args.in[0]);
    PH_END;
    PH_IF LN_PHASE(3, 4, true);
    PH_END;
    PH_IF GEMM_IN(1, XN, MTOK, 4096);
    PH_END;
    PH_IF {
        for (int u = gw; u < NBATCH * 16 * 32; u += NGW) { const int j = u & 31, bh = u >> 5, b = bh >> 4, h = bh & 15;
            const bf16_t* kp = QKV + (size_t)(b * SEQ + j * 256 + (lane >> 3)) * 4096 + 1024 + h * 64 + 8 * (lane & 7);
            float a[8] = {0.f, 0.f, 0.f, 0.f, 0.f, 0.f, 0.f, 0.f};
#pragma unroll 4
            for (int i = 0; i < 32; ++i) { const u32x4 w = *(const u32x4*)(kp + (size_t)(8 * i) * 4096);
                a[0] += bflo(w.x); a[1] += bfhi(w.x); a[2] += bflo(w.y); a[3] += bfhi(w.y); a[4] += bflo(w.z); a[5] += bfhi(w.z); a[6] += bflo(w.w); a[7] += bfhi(w.w); }
#pragma unroll
            for (int e = 0; e < 8; ++e) { a[e] += __shfl_xor(a[e], 8); a[e] += __shfl_xor(a[e], 16); a[e] += __shfl_xor(a[e], 32); a[e] *= (1.f / 256.f); }
            if (lane < 8) { unsigned hh[8], ll[8];
#pragma unroll
                for (int e = 0; e < 8; ++e) { hh[e] = f2bf(a[e]); ll[e] = f2bf(a[e] - __builtin_bit_cast(float, hh[e] << 16)); }
                u32x4 wh, wl; wh.x = hh[0] | (hh[1] << 16); wh.y = hh[2] | (hh[3] << 16); wh.z = hh[4] | (hh[5] << 16); wh.w = hh[6] | (hh[7] << 16);
                wl.x = ll[0] | (ll[1] << 16); wl.y = ll[2] | (ll[3] << 16); wl.z = ll[4] | (ll[5] << 16); wl.w = ll[6] | (ll[7] << 16);
                *(u32x4*)(KMH + (size_t)u * 64 + 8 * lane) = wh; *(u32x4*)(KML + (size_t)u * 64 + 8 * lane) = wl; }
        }
    }
    PH_END;
    PH_IF {
        for (int u = gw; u < NBATCH * 16 * (SEQ / QW); u += NGW) { const int bh = u & 63; int q64 = u >> 6; if ((q64 >> 5) & 1) q64 = (q64 & ~31) + 31 - (q64 & 31);
            moba_own_unit(QKV, KMH, KML, YG, LSE0, SEL, bh >> 4, bh & 15, q64 * QW, vst, lane); }
    }
    PH_END;
    PH_IF {
        const int c = (int)blockIdx.x;
        for (int k = 0;; ++k) { const int U = k * G + ((k & 1) ? (G - 1 - c) : c); if (k * G >= 31 * 64) break; if (U >= 31 * 64) continue;
            const int j = U >> 6, bh = U & 63; moba_routed_unit(QKV, SEL, YG, LSE0, PA, LSEA, PB, LSEB, bh >> 4, bh & 15, j, ldsl, tid); }
        __syncthreads();
    }
    PH_END;
    PH_IF {
        const int gt = blockIdx.x * (NWAVES * 64) + tid, NGT = G * NWAVES * 64;
        for (int idx = gt; idx < MTOK * 128; idx += NGT) { const int row = idx >> 7, c8 = (idx & 127) * 8, h = c8 >> 6, b = row >> 13, t = row & (SEQ - 1);
            const int nsel = __builtin_popcount(SEL[(size_t)(b * 16 + h) * SEQ + t]);
            const float l0 = LSE0[(size_t)row * 16 + h], l1 = nsel >= 2 ? LSEA[(size_t)row * 16 + h] : -__builtin_inff(), l2 = nsel >= 3 ? LSEB[(size_t)row * 16 + h] : -__builtin_inff();
            const float mx = fmaxf(l0, fmaxf(l1, l2)); float w0 = fexp2((l0 - mx) * LOG2E), w1 = fexp2((l1 - mx) * LOG2E), w2 = fexp2((l2 - mx) * LOG2E);
            const float inv = 1.f / (w0 + w1 + w2); w0 *= inv; w1 *= inv; w2 *= inv;
            const size_t off = (size_t)row * DM + c8; const u32x4 zero = {0u, 0u, 0u, 0u};
            const u32x4 a = *(const u32x4*)(YG + off), bq = nsel >= 2 ? *(const u32x4*)(PA + off) : zero, cq = nsel >= 3 ? *(const u32x4*)(PB + off) : zero, z = *(const u32x4*)(QKV + (size_t)row * 4096 + 3072 + c8);
            u32x4 w;
            w.x = pk2((w0 * bflo(a.x) + w1 * bflo(bq.x) + w2 * bflo(cq.x)) * bflo(z.x), (w0 * bfhi(a.x) + w1 * bfhi(bq.x) + w2 * bfhi(cq.x)) * bfhi(z.x));
            w.y = pk2((w0 * bflo(a.y) + w1 * bflo(bq.y) + w2 * bflo(cq.y)) * bflo(z.y), (w0 * bfhi(a.y) + w1 * bfhi(bq.y) + w2 * bfhi(cq.y)) * bfhi(z.y));
            w.z = pk2((w0 * bflo(a.z) + w1 * bflo(bq.z) + w2 * bflo(cq.z)) * bflo(z.z), (w0 * bfhi(a.z) + w1 * bfhi(bq.z) + w2 * bfhi(cq.z)) * bfhi(z.z));
            w.w = pk2((w0 * bflo(a.w) + w1 * bflo(bq.w) + w2 * bflo(cq.w)) * bflo(z.w), (w0 * bfhi(a.w) + w1 * bfhi(bq.w) + w2 * bfhi(cq.w)) * bfhi(z.w));
            *(u32x4*)(YG + off) = w; }
    }
    PH_END;
    PH_IF GEMM_OUT(1, X);
    PH_END;
    PH_IF LN_PHASE(7, 8, true);
    PH_END;
    PH_IF GEMM_IN(2, XN, MTOK, 2560);
    PH_END;
    PH_IF {
        band_lds_phase<0>(QKV, YG, nullptr, args.in[10], ldsl, G, tid);
    }
    PH_END;
    PH_IF GEMM_OUT(2, X);
    PH_END;
    PH_IF LN_PHASE(12, 13, true);
    PH_END;
#pragma unroll 1
    for (int half = 0; half < 2; ++half) {
        PH_IF GEMM_IN(3, XN + (size_t)half * 16384 * DM, 16384, 10240);
        PH_END;
        PH_IF {
            band_lds_phase<1>(QKV, YG, LSE0, nullptr, ldsl, G, tid);
        }
        PH_END;
        PH_IF {
            const int gt = blockIdx.x * (NWAVES * 64) + tid, NGT = G * NWAVES * 64;
            for (int idx = gt; idx < 16384 * 128; idx += NGT) { const int row = idx >> 7, c8 = (idx & 127) * 8, h = c8 >> 6;
                const float l0 = LSE0[(size_t)row * 16 + h], l1 = LSE0[(size_t)(16384 + row) * 16 + h], l2 = LSE0[(size_t)(32768 + row) * 16 + h];
                const float mx = fmaxf(l0, fmaxf(l1, l2)); float w0 = fexp2((l0 - mx) * LOG2E), w1 = fexp2((l1 - mx) * LOG2E), w2 = fexp2((l2 - mx) * LOG2E);
                const float inv = 1.f / (w0 + w1 + w2); w0 *= inv; w1 *= inv; w2 *= inv;
                const bf16_t* rp = QKV + ((size_t)(((row >> 13) * 16 + h) * SEQ) + (row & (SEQ - 1))) * 64 + (c8 & 63); constexpr size_t PST = (size_t)2 * 16 * SEQ * 64;
                const u32x4 a = *(const u32x4*)rp, bq = *(const u32x4*)(rp + 3 * PST), cq = *(const u32x4*)(rp + 6 * PST), z = *(const u32x4*)(rp + 9 * PST);
                u32x4 w;
                w.x = pk2((w0 * bflo(a.x) + w1 * bflo(bq.x) + w2 * bflo(cq.x)) * bflo(z.x), (w0 * bfhi(a.x) + w1 * bfhi(bq.x) + w2 * bfhi(cq.x)) * bfhi(z.x));
                w.y = pk2((w0 * bflo(a.y) + w1 * bflo(bq.y) + w2 * bflo(cq.y)) * bflo(z.y), (w0 * bfhi(a.y) + w1 * bfhi(bq.y) + w2 * bfhi(cq.y)) * bfhi(z.y));
                w.z = pk2((w0 * bflo(a.z) + w1 * bflo(bq.z) + w2 * bflo(cq.z)) * bflo(z.z), (w0 * bfhi(a.z) + w1 * bfhi(bq.z) + w2 * bfhi(cq.z)) * bfhi(z.z));
                w.w = pk2((w0 * bflo(a.w) + w1 * bflo(bq.w) + w2 * bflo(cq.w)) * bflo(z.w), (w0 * bfhi(a.w) + w1 * bfhi(bq.w) + w2 * bfhi(cq.w)) * bfhi(z.w));
                *(u32x4*)(YG + ((size_t)half * 16384 + row) * DM + c8) = w; }
        }
        PH_END;
    }
    PH_IF GEMM_OUT(3, X);
    PH_END;
    PH_IF LN_PHASE(16, 17, false);
#undef IN
#undef PH_IF
#undef PH_END
}

#ifndef N_LAUNCH_MODE
#define N_LAUNCH_MODE 1
#endif
extern "C" void kernel_launch(void* const* d_in, const int* in_sizes, int n_in, void* d_out, int out_size, void* d_ws, size_t ws_size, hipStream_t stream) {
    static int grid = 0;
    if (grid == 0) {
        if (n_in != 18 || in_sizes[0] != MTOK * DM || out_size != MTOK * DM || ws_size < WS_END) { fprintf(stderr, "kernel_launch: unexpected shapes / workspace (n_in %d, ws %zu)\n", n_in, ws_size); grid = -1; return; }
        int dev = 0, cus = 0, per_cu = 0;
        hipGetDevice(&dev); hipDeviceGetAttribute(&cus, hipDeviceAttributeMultiprocessorCount, dev);
        hipFuncSetAttribute((const void*)hybrid_fwd, hipFuncAttributeMaxDynamicSharedMemorySize, LDS_BYTES);
        hipOccupancyMaxActiveBlocksPerMultiprocessor(&per_cu, (const void*)hybrid_fwd, NWAVES * 64, LDS_BYTES);
        (void)hipGetLastError();
        if (per_cu < 1) per_cu = 1;
        grid = cus;
    }
    if (grid < 0) return;
    Args a{};
    for (int i = 0; i < 18; ++i) a.in[i] = (const float*)d_in[i];
    a.out = (float*)d_out; a.ws = (unsigned char*)d_ws;
    if (hipMemsetAsync((char*)d_ws + WS_BAR, 0, BAR_BYTES, stream) != hipSuccess) { fprintf(stderr, "kernel_launch: memset of the barrier words failed\n"); return; }
#if N_LAUNCH_MODE == 1
    a.ph_lo = 0; a.ph_hi = N_PHASES;
    void* params[] = {&a};
    hipError_t e = hipLaunchCooperativeKernel((const void*)hybrid_fwd, dim3(grid), dim3(NWAVES * 64), params, LDS_BYTES, stream);
    if (e != hipSuccess) fprintf(stderr, "cooperative launch failed: %s (grid %d)\n", hipGetErrorString(e), grid);
#else
    for (int p = 0; p < N_PHASES; ++p) { a.ph_lo = p; a.ph_hi = p + 1; hipLaunchKernelGGL(hybrid_fwd, dim3(grid), dim3(NWAVES * 64), LDS_BYTES, stream, a); }
#endif
}
```
